# Optimizing an MI355X kernel written in HIP

```python
import math, functools
import jax, jax.numpy as jnp
from jax import lax
import numpy as np

D_MODEL = 1024
BATCH = 4
SEQ = 4096
DEPTH = 1
DEC_BATCH = 32
DEC_SEQ = 1
PAST_LEN = 8192
PAGE_SIZE = 128

N_META = 16
D_MIX = D_MODEL
D_ATT = D_MIX // 2
D_RNN = D_MIX - D_ATT
HEAD_DIM = 64
N_ATT_HEADS = D_ATT // HEAD_DIM
N_RNN_BLOCKS = 8
RNN_BLOCK = D_RNN // N_RNN_BLOCKS
RNN_CONV = 4
RG_C = 8.0
D_FF = 11 * D_MODEL // 4
FFN_CONV = 3
Q_BLOCK = 128
EPS = 1e-6
ATT_SCALE = HEAD_DIM ** -0.5
FORGET_BIAS_LO = 2.0
FORGET_BIAS_HI = 6.0
D_IN = 3 * D_ATT + N_ATT_HEADS + 2 * D_RNN
SPLIT_IDX = (D_ATT, 2 * D_ATT, 3 * D_ATT, 3 * D_ATT + N_ATT_HEADS, 3 * D_ATT + N_ATT_HEADS + D_RNN)

kernel_name = 'fox_rglru_hymba_decode_step'


def rmsnorm(x, g):
    xf = x.astype(jnp.float32)
    y = xf * lax.rsqrt(jnp.mean(xf * xf, axis=-1, keepdims=True) + EPS) * g.astype(jnp.float32)
    return y.astype(x.dtype)


def causal_dwconv(x, buf, w, b):
    t = x.shape[1]
    width = w.shape[0]
    xp = jnp.concatenate([buf.astype(x.dtype), x], axis=1)
    y = b + sum(w[j] * xp[:, j:j + t] for j in range(width))
    return y, xp[:, t:]


def linear_recurrence(a, u, h0):
    def combine(left, right):
        a_l, u_l = left
        a_r, u_r = right
        return a_l * a_r, a_r * u_l + u_r
    a_cum, u_cum = lax.associative_scan(combine, (a, u), axis=1)
    return a_cum * h0[:, None, :] + u_cum


def forget_attend(q, cq, qpos, k, v, ck, kpos):
    s = jnp.einsum('bqhd,bkhd->bhqk', q, k).astype(jnp.float32) * ATT_SCALE
    s = s + jnp.swapaxes(cq, 1, 2)[:, :, :, None] - jnp.swapaxes(ck, 1, 2)[:, :, None, :]
    s = jnp.where(kpos[None, :] <= qpos[:, None], s, -jnp.inf)
    p = jax.nn.softmax(s, axis=-1)
    return jnp.einsum('bhqk,bkhd->bqhd', p.astype(v.dtype), v)


def prompt_attention(q, k, v, logf):
    b, t = q.shape[:2]
    n_real = t - N_META
    nb = n_real // Q_BLOCK
    c = jnp.cumsum(logf.astype(jnp.float32), axis=1)
    pos = jnp.arange(t)
    o_meta = forget_attend(q[:, :N_META], c[:, :N_META], pos[:N_META],
                           k[:, :N_META], v[:, :N_META], c[:, :N_META], pos[:N_META])
    qb = q[:, N_META:].reshape(b, nb, Q_BLOCK, N_ATT_HEADS, HEAD_DIM).swapaxes(0, 1)
    cb = c[:, N_META:].reshape(b, nb, Q_BLOCK, N_ATT_HEADS).swapaxes(0, 1)
    pb = pos[N_META:].reshape(nb, Q_BLOCK)
    ob = lax.map(lambda blk: forget_attend(blk[0], blk[1], blk[2], k, v, c, pos), (qb, cb, pb))
    o_real = ob.swapaxes(0, 1).reshape(b, n_real, N_ATT_HEADS, HEAD_DIM)
    return jnp.concatenate([o_meta, o_real], axis=1)


def sample_attention(q, k, v, logf, k_past, v_past, logf_past):
    p_len = k_past.shape[1]
    s_len = q.shape[1]
    k_all = jnp.concatenate([k_past.astype(k.dtype), k], axis=1)
    v_all = jnp.concatenate([v_past.astype(v.dtype), v], axis=1)
    c = jnp.cumsum(jnp.concatenate([logf_past.astype(jnp.float32), logf.astype(jnp.float32)], axis=1), axis=1)
    kpos = jnp.arange(p_len + s_len)
    qpos = p_len + jnp.arange(s_len)
    return forget_attend(q, c[:, p_len:], qpos, k_all, v_all, c, kpos)


def rg_lru_branch(xr, gr, conv_buf, h0, lp):
    xc, conv_new = causal_dwconv(xr, conv_buf, lp['rnn_conv_w'], lp['rnn_conv_b'])
    b, t = xc.shape[:2]
    xb = xc.reshape(b, t, N_RNN_BLOCKS, RNN_BLOCK)
    gate_a = jnp.einsum('btnc,ncd->btnd', xb, lp['w_rg_a']).reshape(b, t, D_RNN) + lp['b_rg_a']
    gate_x = jnp.einsum('btnc,ncd->btnd', xb, lp['w_rg_x']).reshape(b, t, D_RNN) + lp['b_rg_x']
    r = jax.nn.sigmoid(gate_a.astype(jnp.float32))
    i = jax.nn.sigmoid(gate_x.astype(jnp.float32))
    log_a = -RG_C * r * jax.nn.softplus(-lp['rg_lambda'].astype(jnp.float32))
    a = jnp.exp(log_a)
    u = jnp.sqrt(-jnp.expm1(2.0 * log_a)) * (i * xc.astype(jnp.float32))
    h = linear_recurrence(a, u, h0.astype(jnp.float32))
    y = h * jax.nn.gelu(gr.astype(jnp.float32))
    return y.astype(xr.dtype), h[:, -1], conv_new


def gated_conv_ffn(hn, buf, lp):
    g_pre, val = jnp.split(hn @ lp['w_ffn_up'], 2, axis=-1)
    g, buf_new = causal_dwconv(g_pre, buf, lp['ffn_conv_w'], lp['ffn_conv_b'])
    return (jax.nn.gelu(g) * val) @ lp['w_ffn_down'], buf_new


def layer_forward(x, attention, rnn_conv_buf, rnn_h0, ffn_buf, lp):
    b, t = x.shape[:2]
    hn = rmsnorm(x, lp['norm_mix'])
    q, k, v, f_logit, xr, gr = jnp.split(hn @ lp['w_in'], SPLIT_IDX, axis=-1)
    q = q.reshape(b, t, N_ATT_HEADS, HEAD_DIM)
    k = k.reshape(b, t, N_ATT_HEADS, HEAD_DIM)
    v = v.reshape(b, t, N_ATT_HEADS, HEAD_DIM)
    logf = jax.nn.log_sigmoid(f_logit.astype(jnp.float32) + lp['b_forget'].astype(jnp.float32))
    att = attention(q, k, v, logf).reshape(b, t, D_ATT)
    rnn, h_last, rnn_conv_new = rg_lru_branch(xr, gr, rnn_conv_buf, rnn_h0, lp)
    merged = jnp.concatenate([rmsnorm(att, lp['norm_att_out']), rmsnorm(rnn, lp['norm_rnn_out'])], axis=-1)
    x = x + merged @ lp['w_out']
    f, ffn_new = gated_conv_ffn(rmsnorm(x, lp['norm_ffn']), ffn_buf, lp)
    x = x + f
    return x, (k, v, logf, h_last, rnn_conv_new, ffn_new)


def setup_inputs(seed: int = 0) -> dict:
    key = jax.random.key(seed)
    ks = jax.random.split(key, 32)
    f32 = jnp.float32
    n_pages = PAST_LEN // PAGE_SIZE
    n_used = DEC_BATCH * n_pages
    n_pool = n_used + max(1, n_used // 4)

    def nrm(k, shape, scale=1.0):
        return scale * jax.random.normal(k, shape, f32)

    head_bias = jnp.linspace(FORGET_BIAS_LO, FORGET_BIAS_HI, N_ATT_HEADS, dtype=f32)
    u = jax.random.uniform(ks[19], (DEPTH, D_RNN), f32, 0.9, 0.999)
    s = u ** (1.0 / RG_C)
    return {
        'x_prompt': nrm(ks[0], (BATCH, SEQ, D_MODEL)),
        'x_sample': nrm(ks[1], (DEC_BATCH, DEC_SEQ, D_MODEL)),
        'cache_k': nrm(ks[2], (DEPTH, n_pool, PAGE_SIZE, N_ATT_HEADS, HEAD_DIM)),
        'cache_v': nrm(ks[3], (DEPTH, n_pool, PAGE_SIZE, N_ATT_HEADS, HEAD_DIM)),
        'cache_logf': jax.nn.log_sigmoid(head_bias + nrm(ks[4], (DEPTH, n_pool, PAGE_SIZE, N_ATT_HEADS))),
        'state_rnn_h': nrm(ks[5], (DEPTH, DEC_BATCH, D_RNN), 0.5),
        'state_rnn_conv': nrm(ks[6], (DEPTH, DEC_BATCH, RNN_CONV - 1, D_RNN)),
        'state_ffn_conv': nrm(ks[7], (DEPTH, DEC_BATCH, FFN_CONV - 1, D_FF)),
        'page_table': jax.random.permutation(ks[8], n_pool)[:n_used].reshape(DEC_BATCH, n_pages).astype(jnp.int32),
        'meta_tokens': nrm(ks[9], (N_META, D_MODEL)),
        'norm_mix': 1.0 + nrm(ks[10], (DEPTH, D_MODEL), 0.02),
        'w_in': nrm(ks[11], (DEPTH, D_MODEL, D_IN), D_MODEL ** -0.5),
        'b_forget': head_bias + nrm(ks[12], (DEPTH, N_ATT_HEADS), 0.1),
        'rnn_conv_w': nrm(ks[13], (DEPTH, RNN_CONV, D_RNN), RNN_CONV ** -0.5),
        'rnn_conv_b': nrm(ks[14], (DEPTH, D_RNN), 0.02),
        'w_rg_a': nrm(ks[15], (DEPTH, N_RNN_BLOCKS, RNN_BLOCK, RNN_BLOCK), RNN_BLOCK ** -0.5),
        'b_rg_a': nrm(ks[16], (DEPTH, D_RNN), 0.02),
        'w_rg_x': nrm(ks[17], (DEPTH, N_RNN_BLOCKS, RNN_BLOCK, RNN_BLOCK), RNN_BLOCK ** -0.5),
        'b_rg_x': nrm(ks[18], (DEPTH, D_RNN), 0.02),
        'rg_lambda': jnp.log(s) - jnp.log1p(-s),
        'norm_att_out': 1.0 + nrm(ks[20], (DEPTH, D_ATT), 0.02),
        'norm_rnn_out': 1.0 + nrm(ks[21], (DEPTH, D_RNN), 0.02),
        'w_out': nrm(ks[22], (DEPTH, D_MIX, D_MODEL), D_MIX ** -0.5),
        'norm_ffn': 1.0 + nrm(ks[23], (DEPTH, D_MODEL), 0.02),
        'w_ffn_up': nrm(ks[24], (DEPTH, D_MODEL, 2 * D_FF), D_MODEL ** -0.5),
        'ffn_conv_w': nrm(ks[25], (DEPTH, FFN_CONV, D_FF), FFN_CONV ** -0.5),
        'ffn_conv_b': nrm(ks[26], (DEPTH, D_FF), 0.02),
        'w_ffn_down': nrm(ks[27], (DEPTH, D_FF, D_MODEL), D_FF ** -0.5),
        'norm_final': 1.0 + nrm(ks[28], (D_MODEL,), 0.02),
    }


def reference(x_prompt, x_sample, cache_k, cache_v, cache_logf, state_rnn_h, state_rnn_conv,
              state_ffn_conv, page_table, meta_tokens, norm_mix, w_in, b_forget, rnn_conv_w,
              rnn_conv_b, w_rg_a, b_rg_a, w_rg_x, b_rg_x, rg_lambda, norm_att_out, norm_rnn_out,
              w_out, norm_ffn, w_ffn_up, ffn_conv_w, ffn_conv_b, w_ffn_down, norm_final):
    b = x_prompt.shape[0]
    db = x_sample.shape[0]
    xp = jnp.concatenate([jnp.broadcast_to(meta_tokens.astype(x_prompt.dtype)[None], (b, N_META, D_MODEL)),
                          x_prompt], axis=1)
    xs = x_sample
    kp_l, vp_l, fp_l, hp_l, rcp_l, fcp_l = [], [], [], [], [], []
    ks_l, vs_l, fs_l, hs_l, rcs_l, fcs_l = [], [], [], [], [], []
    for l in range(DEPTH):
        lp = {
            'norm_mix': norm_mix[l], 'w_in': w_in[l], 'b_forget': b_forget[l],
            'rnn_conv_w': rnn_conv_w[l], 'rnn_conv_b': rnn_conv_b[l],
            'w_rg_a': w_rg_a[l], 'b_rg_a': b_rg_a[l], 'w_rg_x': w_rg_x[l], 'b_rg_x': b_rg_x[l],
            'rg_lambda': rg_lambda[l], 'norm_att_out': norm_att_out[l], 'norm_rnn_out': norm_rnn_out[l],
            'w_out': w_out[l], 'norm_ffn': norm_ffn[l], 'w_ffn_up': w_ffn_up[l],
            'ffn_conv_w': ffn_conv_w[l], 'ffn_conv_b': ffn_conv_b[l], 'w_ffn_down': w_ffn_down[l],
        }
        xp, (kp, vp, fp, hp, rcp, fcp) = layer_forward(
            xp, prompt_attention,
            jnp.zeros((b, RNN_CONV - 1, D_RNN), xp.dtype),
            jnp.zeros((b, D_RNN), jnp.float32),
            jnp.zeros((b, FFN_CONV - 1, D_FF), xp.dtype), lp)
        k_past = cache_k[l][page_table].reshape(db, -1, N_ATT_HEADS, HEAD_DIM)
        v_past = cache_v[l][page_table].reshape(db, -1, N_ATT_HEADS, HEAD_DIM)
        f_past = cache_logf[l][page_table].reshape(db, -1, N_ATT_HEADS)
        att_fn = functools.partial(sample_attention, k_past=k_past, v_past=v_past, logf_past=f_past)
        xs, (kn, vn, fn, hn, rcn, fcn) = layer_forward(
            xs, att_fn, state_rnn_conv[l], state_rnn_h[l], state_ffn_conv[l], lp)
        kp_l.append(kp); vp_l.append(vp); fp_l.append(fp); hp_l.append(hp); rcp_l.append(rcp); fcp_l.append(fcp)
        ks_l.append(kn); vs_l.append(vn); fs_l.append(fn); hs_l.append(hn); rcs_l.append(rcn); fcs_l.append(fcn)
    y_prompt = rmsnorm(xp, norm_final)[:, N_META:]
    y_sample = rmsnorm(xs, norm_final)
    return (y_prompt, y_sample,
            jnp.stack(kp_l), jnp.stack(vp_l), jnp.stack(fp_l), jnp.stack(hp_l), jnp.stack(rcp_l), jnp.stack(fcp_l),
            jnp.stack(ks_l), jnp.stack(vs_l), jnp.stack(fs_l), jnp.stack(hs_l), jnp.stack(rcs_l), jnp.stack(fcs_l))
```

```cpp
#ifndef DIAG
#define DIAG 0
#endif
#ifndef DIAG_TOL
#define DIAG_TOL 0.03f
#endif
#ifndef DIAG_MAG
#define DIAG_MAG 0
#endif
#include <hip/hip_runtime.h>
#include <hip/hip_bf16.h>
#include <cstdio>
#include <cstdint>
#include <cmath>
__device__ __forceinline__ int mk_lane() { int l = (int)__builtin_amdgcn_mbcnt_hi(~0u, __builtin_amdgcn_mbcnt_lo(~0u, 0u)); asm volatile("" : "+v"(l)); return l; }
__device__ __forceinline__ int mk_tid(int wave) { return wave * 64 + mk_lane(); }
namespace pg8 {
#define PG8_LAS __attribute__((address_space(3)))
typedef unsigned short bf16_t;
typedef short bf16x8 __attribute__((ext_vector_type(8)));
typedef float f32x4 __attribute__((ext_vector_type(4)));
typedef unsigned u32x4 __attribute__((ext_vector_type(4)));
constexpr int BM = 256, BK = 64, HALF = 128, HTB = HALF * BK * 2  , STAGE_BYTES = 8 * HTB, NXCD = 8, WGM = 8;

__host__ __device__ __forceinline__ int lds_byte(int r, int c) { const int st = (r >> 4) * 2 + (c >> 5), rr = r & 15, cc = c & 31, ob = rr * 64 + cc * 2; return st * 1024 + (ob ^ (((ob >> 9) & 1) << 5)); }
__host__ __device__ __forceinline__ void stage_rc(int b, int& R, int& C) { const int st = b / 1024, sb = b % 1024, swz = sb ^ (((sb >> 9) & 1) << 5); R = (st >> 1) * 16 + swz / 64; C = (st & 1) * 32 + (swz % 64) / 2; }
__host__ __device__ __forceinline__ int perm32(int rho) { const int n = rho >> 4, i = rho & 15; return 8 * (i >> 2) + 4 * n + (i & 3); }

struct Unit { int pm, pn; };
struct Gemm { const bf16_t* A; const bf16_t* Bt; int M, N, K; };

struct StaticOrder {
    int nM, nN, nwg, G, c;
    __host__ __device__ void init(int M, int N, int G_, int c_) { nM = M / BM; nN = N / BM; nwg = nM * nN; G = G_; c = c_; }
    __host__ __device__ bool next(int i, Unit& u) const {
        const long L = (long)i * G + c; if (L >= nwg) return false;
        int wgid = (int)L; { const int q = nwg / NXCD, r = nwg % NXCD, xcd = wgid % NXCD, off = wgid / NXCD; wgid = (xcd < r ? xcd * (q + 1) : r * (q + 1) + (xcd - r) * q) + off; }
        const int nig = WGM * nN, gid = wgid / nig, fm = gid * WGM, gsz = (nM - fm) < WGM ? (nM - fm) : WGM;
        u.pm = fm + ((wgid % nig) % gsz); u.pn = (wgid % nig) / gsz; return true;
    }
    __device__ __forceinline__ void a_ready(const Unit&) const {}
    __device__ __forceinline__ void done(const Unit&) const {}
};

__device__ __forceinline__ unsigned cvt_pk_bf16(float lo, float hi) { unsigned r; asm volatile("v_cvt_pk_bf16_f32 %0, %1, %2" : "=v"(r) : "v"(lo), "v"(hi)); return r; }
typedef float f32x2 __attribute__((ext_vector_type(2)));
__device__ __forceinline__ f32x2 gelu_pk(f32x2 v) {
    const f32x2 av = __builtin_elementwise_abs(v), d = av * 0.2316418882f + 1.0f;
    f32x2 t; t.x = __builtin_amdgcn_rcpf(d.x); t.y = __builtin_amdgcn_rcpf(d.y);
    f32x2 q = t * 0.5307027145f + (-0.7265760135f); q = q * t + 0.7107068705f; q = q * t + (-0.142248368f); q = q * t + 0.127414796f; q = q * t;
    const f32x2 s = (v * v) * (-0.72134752044f);
    f32x2 e; e.x = __builtin_amdgcn_exp2f(s.x); e.y = __builtin_amdgcn_exp2f(s.y);
    const f32x2 m = v * (q * e), r = v - m;
    f32x2 o; o.x = v.x < 0.f ? m.x : r.x; o.y = v.y < 0.f ? m.y : r.y; return o;
}

template <int ACT  > struct EpiBf16 {
    static constexpr bool PERM = true, AFTER_DRAIN = false; static_assert(ACT == 0 || ACT == 1, "EpiBf16: ACT is 0 (none) or 1 (gelu_pk)");
    bf16_t* O; int ldc; const float* bias; int split_cols; size_t split_stride; float scale0;
    __device__ __forceinline__ void operator()(const f32x4 (&acc)[2][2][4][2], const Unit& u, int wr, int wc, int fr, int fq) const {
        const int row0 = u.pm * BM + wr * 64 + fr; int colt = u.pn * BM; bf16_t* base = O;
        float sc = 1.f; if (split_cols) { const int t = colt / split_cols; base += (size_t)t * split_stride; colt -= t * split_cols; if (t == 0) sc = scale0; }
        const int col0 = colt + wc * 32 + 8 * fq, bcol0 = u.pn * BM + wc * 32 + 8 * fq;
        f32x4 bv[2][2];
#pragma unroll
        for (int bj = 0; bj < 2; ++bj)
#pragma unroll
            for (int n = 0; n < 2; ++n) bv[bj][n] = bias ? *(const f32x4*)(bias + bcol0 + bj * HALF + 4 * n) : (f32x4){0.f, 0.f, 0.f, 0.f};
#pragma unroll
        for (int ai = 0; ai < 2; ++ai)
#pragma unroll
            for (int m = 0; m < 4; ++m) { bf16_t* rowp = base + (size_t)(row0 + ai * HALF + m * 16) * ldc + col0;
#pragma unroll
                for (int bj = 0; bj < 2; ++bj) { f32x4 v0 = acc[ai][bj][m][0] + bv[bj][0], v1 = acc[ai][bj][m][1] + bv[bj][1];
                    if (ACT == 1) { f32x2 a = gelu_pk((f32x2){v0[0], v0[1]}), b = gelu_pk((f32x2){v0[2], v0[3]}), c = gelu_pk((f32x2){v1[0], v1[1]}), d = gelu_pk((f32x2){v1[2], v1[3]});
                        v0 = (f32x4){a.x, a.y, b.x, b.y}; v1 = (f32x4){c.x, c.y, d.x, d.y}; }
                    v0 = v0 * sc; v1 = v1 * sc; u32x4 w; w.x = cvt_pk_bf16(v0[0], v0[1]); w.y = cvt_pk_bf16(v0[2], v0[3]); w.z = cvt_pk_bf16(v1[0], v1[1]); w.w = cvt_pk_bf16(v1[2], v1[3]);
                    *(u32x4*)(rowp + bj * HALF) = w; } }
    }
};

struct PanelStats {
    unsigned* xbuf;
    unsigned* cnt;
    unsigned* tmo;
    int ntn; float eps;
    unsigned code;
    __device__ __forceinline__ bool run(const f32x4 (&v)[2][2][4][2], const Unit& u, int wr, int wc, int fr, int fq, PG8_LAS unsigned char* lds, int wid, int lane) const {
        typedef float f32x2v __attribute__((ext_vector_type(2)));
        PG8_LAS f32x2v* P = (PG8_LAS f32x2v*)lds;
        PG8_LAS f32x2v* S = (PG8_LAS f32x2v*)(lds + 8192);
        PG8_LAS unsigned* flag = (PG8_LAS unsigned*)(lds + 8192 + 2048);
#pragma unroll
        for (int ai = 0; ai < 2; ++ai)
#pragma unroll
            for (int m = 0; m < 4; ++m) {
                float s = 0.f;
#pragma unroll
                for (int bj = 0; bj < 2; ++bj)
#pragma unroll
                    for (int n = 0; n < 2; ++n) { const f32x4 x = v[ai][bj][m][n]; s += (x[0] + x[1]) + (x[2] + x[3]); }
                s += __shfl_xor(s, 16); s += __shfl_xor(s, 32);
                const float mw = s * (1.0f / 64.0f); float q = 0.f;
#pragma unroll
                for (int bj = 0; bj < 2; ++bj)
#pragma unroll
                    for (int n = 0; n < 2; ++n) { const f32x4 d = v[ai][bj][m][n] - mw; q += (d[0] * d[0] + d[1] * d[1]) + (d[2] * d[2] + d[3] * d[3]); }
                q += __shfl_xor(q, 16); q += __shfl_xor(q, 32);
                if (fq == 0) P[(ai * HALF + wr * 64 + m * 16 + fr) * 4 + wc] = (f32x2v){mw, q};
            }
        asm volatile("s_waitcnt lgkmcnt(0)" ::: "memory"); __builtin_amdgcn_s_barrier(); asm volatile("" ::: "memory");
#if defined(BROKEN_EXCHANGE_NO_WAIT)
#warning BROKEN CONTROL BUILD: the row-statistics exchange does not wait; results are wrong by design
        if (blockIdx.x >= 64) { const long long t0_ = clock64(); while (clock64() - t0_ < 60000) __builtin_amdgcn_s_sleep(8); }
#endif
        const int row = wid * 32 + (lane & 31);
        if (lane < 32) {
            const f32x2v a = P[row * 4 + 0], b = P[row * 4 + 1], c = P[row * 4 + 2], d = P[row * 4 + 3];
            const float mt = (a.x + b.x + c.x + d.x) * 0.25f;
            const float da = a.x - mt, db = b.x - mt, dc = c.x - mt, dd = d.x - mt;
            const float m2 = (a.y + b.y) + (c.y + d.y) + 64.0f * ((da * da + db * db) + (dc * dc + dd * dd));
            unsigned long long* slot = (unsigned long long*)xbuf + ((size_t)(u.pm * BM + row) * 4 + u.pn);
            __hip_atomic_store(slot, ((unsigned long long)__float_as_uint(m2) << 32) | __float_as_uint(mt), __ATOMIC_RELAXED, __HIP_MEMORY_SCOPE_AGENT);
        }
        asm volatile("s_waitcnt vmcnt(0)" ::: "memory");
        if (lane == 0) __hip_atomic_fetch_add(cnt + 64 * u.pm, 1u, __ATOMIC_RELAXED, __HIP_MEMORY_SCOPE_AGENT);
        if (wid == 0) {
            bool dead = false; const unsigned long long t0 = __builtin_amdgcn_s_memrealtime(); const unsigned want = 8u * (unsigned)ntn;
            for (;;) {
#if defined(BROKEN_EXCHANGE_NO_WAIT)
                break;
#endif
                if ((unsigned)__builtin_amdgcn_readfirstlane(__hip_atomic_load(cnt + 64 * u.pm, __ATOMIC_RELAXED, __HIP_MEMORY_SCOPE_AGENT)) >= want) break;
                if (__builtin_amdgcn_s_memrealtime() - t0 > 2000000ull) {
                    if (lane == 0) { unsigned expect = 0u; __hip_atomic_compare_exchange_strong(tmo + 1, &expect, code | (unsigned)(u.pm & 0xff), __ATOMIC_RELAXED, __ATOMIC_RELAXED, __HIP_MEMORY_SCOPE_AGENT);
                                     __hip_atomic_store(tmo, 1u, __ATOMIC_RELAXED, __HIP_MEMORY_SCOPE_AGENT); }
                    dead = true; break; }
                __builtin_amdgcn_s_sleep(2);
            }
            __builtin_amdgcn_fence(__ATOMIC_ACQUIRE, "agent");
            if (lane == 0) flag[0] = dead ? 1u : 0u;
        }
        asm volatile("s_waitcnt vmcnt(0) lgkmcnt(0)" ::: "memory"); __builtin_amdgcn_s_barrier(); asm volatile("" ::: "memory");
        const bool bad = flag[0] != 0u;
        if (lane < 32) {
            const unsigned long long* slot = (const unsigned long long*)xbuf + (size_t)(u.pm * BM + row) * 4; float mt[4], m2[4]; float ms = 0.f;
#pragma unroll
            for (int t = 0; t < 4; ++t) { if (t < ntn) { const unsigned long long w = __hip_atomic_load(slot + t, __ATOMIC_RELAXED, __HIP_MEMORY_SCOPE_AGENT); mt[t] = __uint_as_float((unsigned)w); m2[t] = __uint_as_float((unsigned)(w >> 32)); } else { mt[t] = 0.f; m2[t] = 0.f; } ms += mt[t]; }
            const float mean = ms / (float)ntn; float q = 0.f;
#pragma unroll
            for (int t = 0; t < 4; ++t) if (t < ntn) { const float dm = mt[t] - mean; q += m2[t] + 256.0f * dm * dm; }
            S[row] = (f32x2v){mean, 1.0f / sqrtf(q / (256.0f * (float)ntn) + eps)};
        }
        asm volatile("s_waitcnt lgkmcnt(0)" ::: "memory"); __builtin_amdgcn_s_barrier(); asm volatile("" ::: "memory");
        return bad;
    }
};
struct EpiLnRes {
    static constexpr bool PERM = false, AFTER_DRAIN = true;
    const float* base; float* out; int ldc; const float* bias; PanelStats st; unsigned poison;
    __device__ __forceinline__ void fused(f32x4 (&acc)[2][2][4][2], const Unit& u, int wr, int wc, int fr, int fq, PG8_LAS unsigned char* lds, int wid, int lane) const {
        typedef float f32x2v __attribute__((ext_vector_type(2)));
        const PG8_LAS f32x2v* S = (const PG8_LAS f32x2v*)(lds + 8192);
        const int col0 = u.pn * BM + wc * 32 + 4 * fq;
#pragma unroll
        for (int bj = 0; bj < 2; ++bj)
#pragma unroll
            for (int n = 0; n < 2; ++n) { const f32x4 bv = bias ? *(const f32x4*)(bias + col0 + bj * HALF + n * 16) : (f32x4){0.f, 0.f, 0.f, 0.f};
#pragma unroll
                for (int ai = 0; ai < 2; ++ai)
#pragma unroll
                    for (int m = 0; m < 4; ++m) acc[ai][bj][m][n] += bv; }
        f32x4 pre[4][2][2];
#pragma unroll
        for (int m = 0; m < 4; ++m) { const size_t off = (size_t)(u.pm * BM + wr * 64 + m * 16 + fr) * ldc + col0;
#pragma unroll
            for (int bj = 0; bj < 2; ++bj)
#pragma unroll
                for (int n = 0; n < 2; ++n) pre[m][bj][n] = *(const f32x4*)(base + off + bj * HALF + n * 16); }
        const bool bad = st.run(acc, u, wr, wc, fr, fq, lds, wid, lane) || poison != 0u;
        const float qnan = __builtin_nanf("");
#pragma unroll
        for (int ai = 0; ai < 2; ++ai)
#pragma unroll
            for (int m = 0; m < 4; ++m) { const int r = ai * HALF + wr * 64 + m * 16 + fr; const f32x2v sr = S[r]; const size_t off = (size_t)(u.pm * BM + r) * ldc + col0;
#pragma unroll
                for (int bj = 0; bj < 2; ++bj)
#pragma unroll
                    for (int n = 0; n < 2; ++n) { const f32x4 bs = ai == 0 ? pre[m][bj][n] : *(const f32x4*)(base + off + bj * HALF + n * 16); f32x4 o = bs + (acc[ai][bj][m][n] - sr.x) * sr.y;
                        if (bad) o = (f32x4){qnan, qnan, qnan, qnan}; *(f32x4*)(out + off + bj * HALF + n * 16) = o; }
                if (m & 1) asm volatile("" ::: "memory"); }
    }
};
struct EpiLnResLn {
    static constexpr bool PERM = false, AFTER_DRAIN = true;
    const float* base; float* out; bf16_t* xn; int ldc; const float* bias; PanelStats st1, st2; unsigned poison;
    __device__ __forceinline__ void fused(f32x4 (&acc)[2][2][4][2], const Unit& u, int wr, int wc, int fr, int fq, PG8_LAS unsigned char* lds, int wid, int lane) const {
        typedef float f32x2v __attribute__((ext_vector_type(2))); typedef unsigned u32x2v __attribute__((ext_vector_type(2)));
        const PG8_LAS f32x2v* S = (const PG8_LAS f32x2v*)(lds + 8192);
        const int col0 = u.pn * BM + wc * 32 + 4 * fq;
#pragma unroll
        for (int bj = 0; bj < 2; ++bj)
#pragma unroll
            for (int n = 0; n < 2; ++n) { const f32x4 bv = bias ? *(const f32x4*)(bias + col0 + bj * HALF + n * 16) : (f32x4){0.f, 0.f, 0.f, 0.f};
#pragma unroll
                for (int ai = 0; ai < 2; ++ai)
#pragma unroll
                    for (int m = 0; m < 4; ++m) acc[ai][bj][m][n] += bv; }
        bool bad = st1.run(acc, u, wr, wc, fr, fq, lds, wid, lane) || poison != 0u;
        const float qnan = __builtin_nanf("");
#pragma unroll
        for (int ai = 0; ai < 2; ++ai)
#pragma unroll
            for (int m = 0; m < 4; ++m) { const int r = ai * HALF + wr * 64 + m * 16 + fr; const f32x2v sr = S[r]; const size_t off = (size_t)(u.pm * BM + r) * ldc + col0;
#pragma unroll
                for (int bj = 0; bj < 2; ++bj)
#pragma unroll
                    for (int n = 0; n < 2; ++n) { const f32x4 bs = *(const f32x4*)(base + off + bj * HALF + n * 16); acc[ai][bj][m][n] = bs + (acc[ai][bj][m][n] - sr.x) * sr.y; }
                asm volatile("" : "+v"(acc[ai][0][m][0]), "+v"(acc[ai][0][m][1]), "+v"(acc[ai][1][m][0]), "+v"(acc[ai][1][m][1]));
                if (m & 1) asm volatile("" ::: "memory"); }
        const bool bad1 = bad;
        bad = st2.run(acc, u, wr, wc, fr, fq, lds, wid, lane) || bad;
#pragma unroll
        for (int ai = 0; ai < 2; ++ai)
#pragma unroll
            for (int m = 0; m < 4; ++m) { const int r = ai * HALF + wr * 64 + m * 16 + fr; const f32x2v sr = S[r]; const size_t off = (size_t)(u.pm * BM + r) * ldc + col0;
#pragma unroll
                for (int bj = 0; bj < 2; ++bj)
#pragma unroll
                    for (int n = 0; n < 2; ++n) { const f32x4 x1 = acc[ai][bj][m][n]; *(f32x4*)(out + off + bj * HALF + n * 16) = bad1 ? (f32x4){qnan, qnan, qnan, qnan} : x1;
                        const f32x4 o = (x1 - sr.x) * sr.y; u32x2v w; w.x = cvt_pk_bf16(o[0], o[1]); w.y = cvt_pk_bf16(o[2], o[3]);
                        if (bad) { w.x = 0x7fc07fc0u; w.y = 0x7fc07fc0u; } *(u32x2v*)(xn + off + bj * HALF + n * 16) = w; }
                asm volatile("" ::: "memory"); }
    }
};

template <class Epi, class Sched, bool ALIGN_EPI = false, bool SP2 = false>
__device__ __forceinline__ void gemm_phase(PG8_LAS unsigned char* lds, const Gemm g, const Sched& S, const Epi& E, const int wave_in) {
    const int tid = mk_tid(wave_in), wid = wave_in, lane = tid & 63, wr = wid >> 2, wc = wid & 3, fr = lane & 15, fq = lane >> 4;
    const int K = g.K, nt = K / BK;
    unsigned voffA[2], voffB[2];
#pragma unroll
    for (int i = 0; i < 2; ++i) { int R, C; stage_rc(tid * 16 + i * 8192, R, C); const int Rb = Epi::PERM ? ((R & ~31) + perm32(R & 31)) : R;
        voffA[i] = (unsigned)(R * K + C) * 2u; voffB[i] = (unsigned)(Rb * K + C) * 2u; }
    const size_t kstep = (size_t)(BK * 2);
    const size_t hstep = (size_t)HALF * K * 2;
    const size_t tstep = 2 * hstep;
    const unsigned ldsw = (unsigned)wid * 1024u;
    const int aoff = lds_byte(wr * 64 + fr, fq * 8), boff = lds_byte(wc * 32 + fr, fq * 8);
#define PG8_SA(b, h) (((b) * 2 + (h)) * HTB)
#define PG8_SB(b, h) ((4 + (b) * 2 + (h)) * HTB)
#define PG8_STAGE(bufoff, gbase, voff) do { _Pragma("unroll") for (int _i = 0; _i < 2; ++_i) \
        __builtin_amdgcn_global_load_lds((const unsigned*)((const char*)(gbase) + (voff)[_i]), (PG8_LAS unsigned*)(lds + (bufoff) + ldsw + _i * 8192), 16, 0, 0); } while (0)
#define PG8_LDA(dst, b, h) do { _Pragma("unroll") for (int m = 0; m < 4; ++m) _Pragma("unroll") for (int k = 0; k < 2; ++k) dst[m][k] = *(const PG8_LAS bf16x8*)(lds + PG8_SA(b, h) + aoff + m * 2048 + k * 1024); } while (0)
#define PG8_LDB(dst, b, h) do { _Pragma("unroll") for (int n = 0; n < 2; ++n) _Pragma("unroll") for (int k = 0; k < 2; ++k) dst[n][k] = *(const PG8_LAS bf16x8*)(lds + PG8_SB(b, h) + boff + n * 2048 + k * 1024); } while (0)
#define PG8_MMA(ai, bj, At, Bt) do { __builtin_amdgcn_s_setprio(1); _Pragma("unroll") for (int m = 0; m < 4; ++m) _Pragma("unroll") for (int n = 0; n < 2; ++n) _Pragma("unroll") for (int k = 0; k < 2; ++k) \
        acc[ai][bj][m][n] = __builtin_amdgcn_mfma_f32_16x16x32_bf16(Bt[n][k], At[m][k], acc[ai][bj][m][n], 0, 0, 0); __builtin_amdgcn_s_setprio(0); } while (0)
#define PG8_WAIT_V(n) asm volatile("s_waitcnt vmcnt(" #n ")" ::: "memory")
#define PG8_WAIT_L(n) asm volatile("s_waitcnt lgkmcnt(" #n ")" ::: "memory")
#define PG8_BAR __builtin_amdgcn_s_barrier()
#define PG8_SCHED __builtin_amdgcn_sched_barrier(0)
    Unit cur, nxt; int ui = 0;
    if (!S.next(0, cur)) return;
    f32x4 acc[2][2][4][2];
#pragma unroll
    for (int a = 0; a < 2; ++a)
#pragma unroll
        for (int b = 0; b < 2; ++b)
#pragma unroll
            for (int m = 0; m < 4; ++m)
#pragma unroll
                for (int n = 0; n < 2; ++n) acc[a][b][m][n] = (f32x4){0.f, 0.f, 0.f, 0.f};
    bf16x8 At[4][2], B0[2][2], B1[2][2];
    const char* cA = (const char*)g.A + (size_t)cur.pm * tstep; const char* cB = (const char*)g.Bt + (size_t)cur.pn * tstep;
    S.a_ready(cur);
    if constexpr (SP2) {
        PG8_STAGE(PG8_SB(0, 0), cB, voffB); PG8_STAGE(PG8_SB(0, 1), cB + hstep, voffB); PG8_STAGE(PG8_SA(0, 0), cA, voffA); PG8_STAGE(PG8_SA(0, 1), cA + hstep, voffA);
        if (wr == 1) PG8_BAR;
        PG8_WAIT_V(2); PG8_BAR;
        PG8_STAGE(PG8_SB(1, 0), cB + kstep, voffB); PG8_STAGE(PG8_SA(1, 0), cA + kstep, voffA); PG8_STAGE(PG8_SB(1, 1), cB + hstep + kstep, voffB);
        PG8_WAIT_V(6); PG8_BAR;
    } else {
        PG8_STAGE(PG8_SB(0, 0), cB, voffB); PG8_STAGE(PG8_SA(0, 0), cA, voffA); PG8_STAGE(PG8_SB(0, 1), cB + hstep, voffB); PG8_STAGE(PG8_SA(0, 1), cA + hstep, voffA);
        if (wr == 1) PG8_BAR;
        PG8_WAIT_V(4); PG8_BAR;
        PG8_STAGE(PG8_SB(1, 0), cB + kstep, voffB); PG8_STAGE(PG8_SA(1, 0), cA + kstep, voffA); PG8_STAGE(PG8_SB(1, 1), cB + hstep + kstep, voffB);
        PG8_WAIT_V(6); PG8_BAR;
    }
    for (;;) {
        const bool has_next = S.next(ui + 1, nxt);
        const char* nA = has_next ? (const char*)g.A + (size_t)nxt.pm * tstep : cA; const char* nB = has_next ? (const char*)g.Bt + (size_t)nxt.pn * tstep : cB;
        for (int t = 0; t < nt; t += 2) {
            const bool last = (t == nt - 2);
            const char* a1 = cA + (size_t)(t + 1) * kstep;
            const char* a2 = last ? nA : cA + (size_t)(t + 2) * kstep; const char* b2 = last ? nB : cB + (size_t)(t + 2) * kstep;
            const char* a3 = a2 + kstep; const char* b3 = b2 + kstep;
            if (last && has_next) S.a_ready(nxt);
            if constexpr (SP2) {
            PG8_LDB(B0, 0, 0); PG8_LDB(B1, 0, 1); PG8_SCHED; PG8_LDA(At, 0, 0); PG8_STAGE(PG8_SA(1, 1), a1 + hstep, voffA);
            PG8_WAIT_V(8); PG8_WAIT_L(0); PG8_BAR; PG8_MMA(0, 0, At, B0); PG8_MMA(0, 1, At, B1); PG8_BAR; PG8_SCHED;
            PG8_LDA(At, 0, 1); PG8_STAGE(PG8_SB(0, 0), b2, voffB); PG8_STAGE(PG8_SB(0, 1), b2 + hstep, voffB); PG8_STAGE(PG8_SA(0, 0), a2, voffA);
            PG8_WAIT_V(8); PG8_WAIT_L(0); PG8_BAR; PG8_MMA(1, 0, At, B0); PG8_MMA(1, 1, At, B1); PG8_BAR; PG8_SCHED;
            PG8_LDB(B0, 1, 0); PG8_LDB(B1, 1, 1); PG8_SCHED; PG8_LDA(At, 1, 0); PG8_STAGE(PG8_SA(0, 1), a2 + hstep, voffA);
            PG8_WAIT_V(8); PG8_WAIT_L(0); PG8_BAR; PG8_MMA(0, 0, At, B0); PG8_MMA(0, 1, At, B1); PG8_BAR; PG8_SCHED;
            PG8_LDA(At, 1, 1); PG8_STAGE(PG8_SB(1, 0), b3, voffB); PG8_STAGE(PG8_SB(1, 1), b3 + hstep, voffB); PG8_STAGE(PG8_SA(1, 0), a3, voffA);
            PG8_WAIT_V(8); PG8_WAIT_L(0); PG8_BAR; PG8_MMA(1, 0, At, B0); PG8_MMA(1, 1, At, B1); PG8_BAR; PG8_SCHED;
            } else {
            PG8_LDB(B0, 0, 0); PG8_SCHED; PG8_LDA(At, 0, 0); PG8_STAGE(PG8_SA(1, 1), a1 + hstep, voffA);
            PG8_WAIT_L(8); PG8_BAR; PG8_WAIT_L(0); PG8_MMA(0, 0, At, B0); PG8_BAR; PG8_SCHED;
            PG8_LDB(B1, 0, 1); PG8_STAGE(PG8_SB(0, 0), b2, voffB);
            PG8_BAR; PG8_WAIT_L(0); PG8_MMA(0, 1, At, B1); PG8_BAR;
            PG8_LDA(At, 0, 1); PG8_STAGE(PG8_SA(0, 0), a2, voffA);
            PG8_BAR; PG8_WAIT_L(0); PG8_MMA(1, 0, At, B0); PG8_BAR; PG8_SCHED;
            PG8_STAGE(PG8_SB(0, 1), b2 + hstep, voffB);
            PG8_WAIT_V(6); PG8_BAR; PG8_MMA(1, 1, At, B1); PG8_BAR;
            PG8_LDB(B0, 1, 0); PG8_SCHED; PG8_LDA(At, 1, 0); PG8_STAGE(PG8_SA(0, 1), a2 + hstep, voffA);
            PG8_WAIT_L(8); PG8_BAR; PG8_WAIT_L(0); PG8_MMA(0, 0, At, B0); PG8_BAR; PG8_SCHED;
            PG8_LDB(B1, 1, 1); PG8_STAGE(PG8_SB(1, 0), b3, voffB);
            PG8_BAR; PG8_WAIT_L(0); PG8_MMA(0, 1, At, B1); PG8_BAR;
            PG8_LDA(At, 1, 1); PG8_STAGE(PG8_SA(1, 0), a3, voffA);
            PG8_BAR; PG8_WAIT_L(0); PG8_MMA(1, 0, At, B0); PG8_BAR; PG8_SCHED;
            PG8_STAGE(PG8_SB(1, 1), b3 + hstep, voffB);
            PG8_WAIT_V(6); PG8_BAR; PG8_MMA(1, 1, At, B1); PG8_BAR;
            }
        }
        if constexpr (ALIGN_EPI) { if (wr == 0) PG8_BAR; }
        if constexpr (!Epi::AFTER_DRAIN) { E(acc, cur, wr, wc, fr, fq); S.done(cur); }
        if (!has_next) break;
#pragma unroll
        for (int a = 0; a < 2; ++a)
#pragma unroll
            for (int b = 0; b < 2; ++b)
#pragma unroll
                for (int m = 0; m < 4; ++m)
#pragma unroll
                    for (int n = 0; n < 2; ++n) acc[a][b][m][n] = (f32x4){0.f, 0.f, 0.f, 0.f};
        cur = nxt; cA = nA; cB = nB; ++ui;
        if constexpr (ALIGN_EPI) { if (wr == 1) PG8_BAR; }
    }
    PG8_WAIT_V(0);
    if constexpr (!ALIGN_EPI) { if (wr == 0) PG8_BAR; }
    PG8_BAR;
    if constexpr (Epi::AFTER_DRAIN) { E.fused(acc, cur, wr, wc, fr, fq, lds, wid, lane); S.done(cur); }
#undef PG8_SA
#undef PG8_SB
#undef PG8_STAGE
#undef PG8_LDA
#undef PG8_LDB
#undef PG8_MMA
#undef PG8_WAIT_V
#undef PG8_WAIT_L
#undef PG8_BAR
#undef PG8_SCHED
}
}

#define PG8_SP2 true
#define PG8_ALIGN true
namespace attn_body {
using bf16=__hip_bfloat16;
using bf16x8=__attribute__((ext_vector_type(8)))short;
using s16x4=__attribute__((ext_vector_type(4)))short;
using f32x16=__attribute__((ext_vector_type(16)))float;
using u32x4=__attribute__((ext_vector_type(4)))unsigned;
constexpr int BATCH=4,NHEAD=8,SEQ=4096,D=64,DM=NHEAD*D,MROW=BATCH*SEQ,CBLEN=64+SEQ;
constexpr int NW=8,QBLK=32,QB=QBLK*NW,KVBLK=64,NQB=SEQ/QB;
constexpr int ATTN_PITCH=DM, ATTN_UNIT_ROWS=QB;
__device__ __forceinline__ int crow(int r,int hi){return (r&3)+8*(r>>2)+4*hi;}
#define SBAR() __builtin_amdgcn_sched_barrier(0)
__device__ __forceinline__ void cmask(f32x16&p0,f32x16&p1,int jb,int qrel,int hi){
  const float NEG=-INFINITY; int kb=64*jb+4*hi;
  #pragma unroll
  for(int r=0;r<16;++r){int kv=kb+(r&3)+8*(r>>2); if(kv>qrel)p0[r]=NEG; if(kv+32>qrel)p1[r]=NEG;}
}

constexpr int NSLOT=3, SLOTB=8192;
constexpr int LDS_K=0, LDS_V=NSLOT*SLOTB, LDS_WS=2*NSLOT*SLOTB, LDS_OST=LDS_WS+NW*64*4, LDS_BIAS=LDS_OST+NW*4096, LDS_BYTES=LDS_BIAS+CBLEN*4;
constexpr float C2=0.125f*1.4426950408889634f;
__device__ __forceinline__ void glds16(const void*gsrc,unsigned lds_dst){unsigned keep;
  asm volatile("s_mov_b32 %0, m0\n\ts_mov_b32 m0, %2\n\ts_nop 0\n\tglobal_load_lds_dwordx4 %1, off\n\ts_mov_b32 m0, %0":"=&s"(keep):"v"(gsrc),"s"(lds_dst):"memory");}
__device__ __forceinline__ float max3f(float a,float b,float c){float r;asm("v_max3_f32 %0, %1, %2, %3":"=v"(r):"v"(a),"v"(b),"v"(c));return r;}
__device__ __forceinline__ float max2f(float a,float b){float r;asm("v_max_f32_e32 %0, %1, %2":"=v"(r):"v"(a),"v"(b));return r;}
__device__ __forceinline__ float fadd_s(float a,float b){float r;asm("v_add_f32_e32 %0, %1, %2":"=v"(r):"v"(a),"v"(b));return r;}
__device__ __forceinline__ float fsub_s(float a,float b){float r;asm("v_sub_f32_e32 %0, %1, %2":"=v"(r):"v"(a),"v"(b));return r;}
typedef float f32x2_t __attribute__((ext_vector_type(2))); typedef __bf16 bf16x2_t __attribute__((ext_vector_type(2)));
__device__ __forceinline__ unsigned cvtpk_s(float lo,float hi){f32x2_t v={lo,hi};bf16x2_t b=__builtin_convertvector(v,bf16x2_t);return __builtin_bit_cast(unsigned,b);}
#define WAIT_BAR(N) asm volatile("s_waitcnt vmcnt(" #N ") lgkmcnt(0)\n\ts_barrier":::"memory")

__device__ __forceinline__ void qkt(f32x16&p0,f32x16&p1,const char*Kslot,const bf16x8*qr,int r32,int hi){
  const char*kb=Kslot+hi*1024+r32*16;
  #pragma unroll
  for(int d0=0;d0<4;++d0){
    const bf16x8 b0=*reinterpret_cast<const bf16x8*>(kb+d0*2048);
    const bf16x8 b1=*reinterpret_cast<const bf16x8*>(kb+d0*2048+512);
    p0=__builtin_amdgcn_mfma_f32_32x32x16_bf16(b0,qr[d0],p0,0,0,0);p1=__builtin_amdgcn_mfma_f32_32x32x16_bf16(b1,qr[d0],p1,0,0,0);}
}
typedef __attribute__((address_space(3))) const char* lds_cptr;
typedef float f32x4_t __attribute__((ext_vector_type(4))); typedef __attribute__((address_space(3))) f32x4_t* lds_f4p;
typedef short v4i16_t __attribute__((ext_vector_type(4)));
__device__ __forceinline__ void kload8(bf16x8*kf,lds_cptr kp){
  kf[0]=*(const __attribute__((address_space(3))) bf16x8*)(kp);      kf[1]=*(const __attribute__((address_space(3))) bf16x8*)(kp+512);
  kf[2]=*(const __attribute__((address_space(3))) bf16x8*)(kp+2048); kf[3]=*(const __attribute__((address_space(3))) bf16x8*)(kp+2560);
  kf[4]=*(const __attribute__((address_space(3))) bf16x8*)(kp+4096); kf[5]=*(const __attribute__((address_space(3))) bf16x8*)(kp+4608);
  kf[6]=*(const __attribute__((address_space(3))) bf16x8*)(kp+6144); kf[7]=*(const __attribute__((address_space(3))) bf16x8*)(kp+6656);
}
__device__ __forceinline__ void kload2(bf16x8*kf,lds_cptr kp,int j){ kf[2*j]=*(const __attribute__((address_space(3))) bf16x8*)(kp+j*2048); kf[2*j+1]=*(const __attribute__((address_space(3))) bf16x8*)(kp+j*2048+512); }
__device__ __forceinline__ s16x4 vtr(lds_cptr p){ return __builtin_bit_cast(s16x4,__builtin_amdgcn_ds_read_tr16_b64_v4i16((__attribute__((address_space(3))) v4i16_t*)p)); }
__device__ __forceinline__ float rowmax(const f32x16&p0,const f32x16&p1){
  float a=max3f(p0[0],p0[1],p1[0]),b=max3f(p0[2],p0[3],p1[1]);a=max3f(a,p1[2],p1[3]);
  #pragma unroll
  for(int r=4;r<16;r+=4){a=max3f(a,p0[r],p0[r+1]);b=max3f(b,p0[r+2],p0[r+3]);a=max3f(a,p1[r],p1[r+1]);b=max3f(b,p1[r+2],p1[r+3]);}
  const float m=max2f(a,b);
  auto rr=__builtin_amdgcn_permlane32_swap(__float_as_uint(m),__float_as_uint(m),false,false);
  return max2f(__uint_as_float(rr[0]),__uint_as_float(rr[1]));
}
__device__ __forceinline__ void pv(f32x16*o,int vb,bf16x8 pa0,bf16x8 pa1,bf16x8 pa2,bf16x8 pa3){
  #pragma unroll
  for(int d0=0;d0<2;++d0){s16x4 lo[4],hi[4];
    #pragma unroll
    for(int ks=0;ks<4;++ks){
      asm volatile("ds_read_b64_tr_b16 %0,%1 offset:%c2":"=&v"(lo[ks]):"v"(vb),"i"(d0*4096+ks*1024):"memory");
      asm volatile("ds_read_b64_tr_b16 %0,%1 offset:%c2":"=&v"(hi[ks]):"v"(vb),"i"(d0*4096+ks*1024+512):"memory");}
    asm volatile("s_waitcnt lgkmcnt(0)":::"memory");SBAR();
    #define PK(k) (bf16x8){lo[k][0],lo[k][1],lo[k][2],lo[k][3],hi[k][0],hi[k][1],hi[k][2],hi[k][3]}
    o[d0]=__builtin_amdgcn_mfma_f32_32x32x16_bf16(pa0,PK(0),o[d0],0,0,0);
    o[d0]=__builtin_amdgcn_mfma_f32_32x32x16_bf16(pa1,PK(1),o[d0],0,0,0);
    o[d0]=__builtin_amdgcn_mfma_f32_32x32x16_bf16(pa2,PK(2),o[d0],0,0,0);
    o[d0]=__builtin_amdgcn_mfma_f32_32x32x16_bf16(pa3,PK(3),o[d0],0,0,0);
    #undef PK
  }
}

#ifndef ATTN_STORE16
#define ATTN_STORE16(p,v) (*(u32x4*)(p)=(v))
#endif
template<int THRL> __device__ __forceinline__ void attn_unit(int b,int h,int qb,const bf16*Q,const bf16*__restrict__ K,const bf16*__restrict__ V,bf16*O,const float*__restrict__ CBg,char*shm,const int wave_in){
  const int tid=threadIdx.x,lane=tid&63,r32=lane&31,hi=lane>>5; const int wid=wave_in;
  const long rowbase=(long)b*SEQ; const int q0=qb*QB;
  const bf16*Qw=Q+(rowbase+q0+wid*QBLK)*DM+h*D;
  const bf16*Kh=K+rowbase*DM+h*D,*Vh=V+rowbase*DM+h*D;
  const unsigned lds0=(unsigned)(uintptr_t)shm;
  float*wsf=(float*)(shm+LDS_WS)+wid*64;
  const bf16*ksrc1=Kh+(long)lane*DM+wid*8-(long)KVBLK*DM;
  const bf16*ksrc_m=K+((long)MROW+lane)*DM+h*D+wid*8;
  const bf16*vsrc1=Vh+(long)(16*(wid&3)+(lane>>2))*DM+(wid>>2)*32+(lane&3)*8-(long)KVBLK*DM;
  const bf16*vsrc_m=V+((long)MROW+16*(wid&3)+(lane>>2))*DM+h*D+(wid>>2)*32+(lane&3)*8;
  const unsigned kdst=lds0+LDS_K+wid*1024, vdst=lds0+LDS_V+wid*1024;
  #define DMA_K(t,slot) glds16(((t)==0)?ksrc_m:ksrc1+(long)(t)*KVBLK*DM,(unsigned)__builtin_amdgcn_readfirstlane(kdst+(slot)))
  #define DMA_V(t,slot) glds16(((t)==0)?vsrc_m:vsrc1+(long)(t)*KVBLK*DM,(unsigned)__builtin_amdgcn_readfirstlane(vdst+(slot)))
  const int vb0=(int)(lds0+LDS_V)+((lane>>4)&1)*32+(lane&3)*8+(4*hi+((lane&15)>>2))*64;
  const char*Kbase=shm+LDS_K; bf16x8 kf[8];
  const lds_cptr shm3=(lds_cptr)shm; const lds_cptr kp0=shm3+LDS_K+hi*1024+r32*16; const lds_cptr vp0=shm3+LDS_V+((lane>>4)&1)*32+(lane&3)*8+(4*hi+((lane&15)>>2))*64;
  const int NT=(q0+QB)/KVBLK+1;
  { const int n4=(64+q0+QB)/4; const lds_f4p bl=(lds_f4p)((lds_cptr)shm+LDS_BIAS);
    for(int i=tid;i<n4;i+=NW*64) bl[i]=*(const f32x4_t*)(CBg+4*i); }
  #define BIAS4(P,T,G,OFF,NEG) do{ const f32x4_t b4_=*(const __attribute__((address_space(3))) f32x4_t*)(bia0+(T)*256+(G)*32+(OFF)); P[4*(G)]=b4_[0]+(NEG);P[4*(G)+1]=b4_[1]+(NEG);P[4*(G)+2]=b4_[2]+(NEG);P[4*(G)+3]=b4_[3]+(NEG); }while(0)
  #define BIAS16(P,T,OFF,NEG) do{ BIAS4(P,T,0,OFF,NEG);BIAS4(P,T,1,OFF,NEG);BIAS4(P,T,2,OFF,NEG);BIAS4(P,T,3,OFF,NEG); }while(0)
  const lds_cptr bia0=(lds_cptr)shm+LDS_BIAS+16*hi;
  DMA_K(0,0);DMA_V(0,0);DMA_K(1,SLOTB);
  bf16x8 qr[4];
  #pragma unroll
  for(int d0=0;d0<4;++d0)qr[d0]=*reinterpret_cast<const bf16x8*>(&Qw[(long)r32*DM+d0*16+hi*8]);
  float mhat=0.f,l_reg=0.f,negs=0.f;f32x16 o[2];o[0]=f32x16{};o[1]=f32x16{};
  const int qrel=wid*QBLK+r32;
  #define CMASK(P0,P1,t) do{int jb_=(t)-(NT-4); if(jb_>=0)cmask(P0,P1,jb_,qrel,hi);}while(0)
  bool resc=false;
  #define START(P0,P1) do{ const float rm=rowmax(P0,P1); resc=false; \
    { const float dl=rm; mhat=fadd_s(mhat,dl); \
      _Pragma("unroll") for(int r=0;r<16;++r){P0[r]=fsub_s(P0[r],dl);P1[r]=fsub_s(P1[r],dl);} \
      negs=-mhat; } \
    _Pragma("unroll") for(int r=0;r<16;++r)P0[r]=__builtin_amdgcn_exp2f(P0[r]); }while(0)
  #define RESC() do{ if(resc){ asm volatile("s_waitcnt lgkmcnt(0)":::"memory"); \
      _Pragma("unroll") for(int d_=0;d_<2;++d_) _Pragma("unroll") for(int r=0;r<16;++r)o[d_][r]*=wsf[crow(r,hi)]; } }while(0)
  f32x16 pA0,pA1,pB0,pB1;
  int sl_prev=0,sl_cur=0,sl_next=SLOTB;
  #define ROT() do{sl_prev=sl_cur;sl_cur=sl_next;sl_next=(sl_next==(NSLOT-1)*SLOTB)?0:sl_next+SLOTB;}while(0)
  DMA_K(2,2*SLOTB);
  WAIT_BAR(3);
  BIAS16(pA0,0,0,0.f);BIAS16(pA1,0,128,0.f);
  qkt(pA0,pA1,Kbase,qr,r32,hi);asm volatile("s_nop 15\n\ts_nop 7":"+v"(pA0),"+v"(pA1));
  START(pA0,pA1);
  BIAS16(pB0,1,0,negs);BIAS16(pB1,1,128,negs);
  _Pragma("unroll") for(int r=0;r<16;++r)pA1[r]=__builtin_amdgcn_exp2f(pA1[r]);
  WAIT_BAR(0);
  DMA_K(3,0);DMA_V(1,SLOTB);
  ROT();
  kload8(kf,kp0+sl_cur);
  WAIT_BAR(2);
  s16x4 vlo[8],vhi[8]; u32x4 pw0,pw1,pw2,pw3;
  #define PKW(P,B) cvtpk_s(P[B],P[B+1])
  #define PAF(k) __builtin_bit_cast(bf16x8,pw##k)
  #define VFR(i) (bf16x8){vlo[i][0],vlo[i][1],vlo[i][2],vlo[i][3],vhi[i][0],vhi[i][1],vhi[i][2],vhi[i][3]}
  #define PIN(x) asm volatile("":"+v"(x))
  #define MX3(a,b,c) __builtin_fmaxf(__builtin_fmaxf((a),(b)),(c))
  #define GAPA(MF,A0,A1,A2,A3,W0,W1,PW) do{ MF; sacc+=A0; sacc+=A1; sacc+=A2; sacc+=A3; PIN(sacc); W0; W1; PIN(PW); SBAR(); }while(0)
  #define EX(v) __builtin_amdgcn_exp2f(v)
  #define GAPB(MF,X,B,BZ) do{ BZ; MF; X[B]=EX(X[B]); X[B+1]=EX(X[B+1]); X[B+2]=EX(X[B+2]); X[B+3]=EX(X[B+3]); PIN(X); SBAR(); }while(0)
  #define BZ4(GB,P,t,G,OFF) do{ if(GB){ BIAS4(P,(t)+1,G,OFF,negs); } }while(0)
  #define VRD(i) do{ vlo[i]=vtr(vp_+(((i)>>2)*4096+((i)&3)*1024)); vhi[i]=vtr(vp_+(((i)>>2)*4096+((i)&3)*1024+512)); }while(0)
  #define KRD(G,j) do{ if(G){ kload2(kf,kp0+sl_next,j); SBAR(); } }while(0)
  #define STEP(C0,C1,P0,P1,t,GK,GV,GL,GB) do{ SBAR(); \
    const lds_cptr vp_=vp0+sl_prev; \
    VRD(0); SBAR(); float sacc=(P0[0]+P0[1]); \
    GAPA(C0=__builtin_amdgcn_mfma_f32_32x32x16_bf16(kf[0],qr[0],C0,0,0,0), P0[2],P0[3],P0[4],P0[5],     pw0[0]=PKW(P0,0), pw0[1]=PKW(P0,2), pw0); \
    VRD(4); SBAR(); GAPA(C1=__builtin_amdgcn_mfma_f32_32x32x16_bf16(kf[1],qr[0],C1,0,0,0), P0[6],P0[7],P0[8],P0[9],     pw0[2]=PKW(P0,4), pw0[3]=PKW(P0,6), pw0); \
    VRD(1); SBAR(); GAPA(C0=__builtin_amdgcn_mfma_f32_32x32x16_bf16(kf[2],qr[1],C0,0,0,0),   P0[10],P0[11],P0[12],P0[13], pw1[0]=PKW(P0,8), pw1[1]=PKW(P0,10), pw1); \
    VRD(5); SBAR(); GAPA(C1=__builtin_amdgcn_mfma_f32_32x32x16_bf16(kf[3],qr[1],C1,0,0,0),   P0[14],P0[15],P1[0],P1[1],   pw1[2]=PKW(P0,12),pw1[3]=PKW(P0,14), pw1); \
    VRD(2); SBAR(); GAPA(C0=__builtin_amdgcn_mfma_f32_32x32x16_bf16(kf[4],qr[2],C0,0,0,0),   P1[2],P1[3],P1[4],P1[5],     pw2[0]=PKW(P1,0), pw2[1]=PKW(P1,2), pw2); \
    VRD(6); SBAR(); GAPA(C1=__builtin_amdgcn_mfma_f32_32x32x16_bf16(kf[5],qr[2],C1,0,0,0),   P1[6],P1[7],P1[8],P1[9],     pw2[2]=PKW(P1,4), pw2[3]=PKW(P1,6), pw2); \
    VRD(3); SBAR(); GAPA(C0=__builtin_amdgcn_mfma_f32_32x32x16_bf16(kf[6],qr[3],C0,0,0,0),   P1[10],P1[11],P1[12],P1[13], pw3[0]=PKW(P1,8), pw3[1]=PKW(P1,10), pw3); \
    VRD(7); SBAR(); GAPA(C1=__builtin_amdgcn_mfma_f32_32x32x16_bf16(kf[7],qr[3],C1,0,0,0),   P1[14],P1[15],0.f,0.f,       pw3[2]=PKW(P1,12),pw3[3]=PKW(P1,14), pw3); \
    l_reg+=sacc; \
    if(GK){DMA_K((t)+3,sl_cur);} if(GV){DMA_V((t)+1,sl_next);} \
    CMASK(C0,C1,t); \
    { float a=MX3(C0[0],C0[1],C1[0]),b=MX3(C0[2],C0[3],C1[1]); a=MX3(a,C1[2],C1[3]); \
      _Pragma("unroll") for(int r=4;r<16;r+=4){a=MX3(a,C0[r],C0[r+1]);b=MX3(b,C0[r+2],C0[r+3]);a=MX3(a,C1[r],C1[r+1]);b=MX3(b,C1[r+2],C1[r+3]);} \
      float rm=__builtin_fmaxf(a,b); { auto rr=__builtin_amdgcn_permlane32_swap(__float_as_uint(rm),__float_as_uint(rm),false,false); rm=__builtin_fmaxf(__uint_as_float(rr[0]),__uint_as_float(rr[1])); } \
      resc=false; \
      if(__builtin_expect(__any(rm>(float)THRL),0)){ const float dl=__builtin_fmaxf(rm,0.f); mhat+=dl; \
        _Pragma("unroll") for(int r=0;r<16;++r){C0[r]-=dl;C1[r]-=dl;} \
        negs=-mhat; \
        const float f=__builtin_amdgcn_exp2f(-dl); l_reg*=f; if(hi==0)wsf[r32]=f; resc=true; } } \
    SBAR(); \
    GAPB(o[0]=__builtin_amdgcn_mfma_f32_32x32x16_bf16(PAF(0),VFR(0),o[0],0,0,0), C0,0, BZ4(GB,P0,t,0,0)); \
    GAPB(o[1]=__builtin_amdgcn_mfma_f32_32x32x16_bf16(PAF(0),VFR(4),o[1],0,0,0), C0,4, BZ4(GB,P0,t,1,0)); \
    KRD(GL,0); GAPB(o[0]=__builtin_amdgcn_mfma_f32_32x32x16_bf16(PAF(1),VFR(1),o[0],0,0,0), C0,8, BZ4(GB,P0,t,2,0)); \
    KRD(GL,1); GAPB(o[1]=__builtin_amdgcn_mfma_f32_32x32x16_bf16(PAF(1),VFR(5),o[1],0,0,0), C0,12, BZ4(GB,P0,t,3,0)); \
    KRD(GL,2); GAPB(o[0]=__builtin_amdgcn_mfma_f32_32x32x16_bf16(PAF(2),VFR(2),o[0],0,0,0), C1,0, BZ4(GB,P1,t,0,128)); \
    KRD(GL,3); GAPB(o[1]=__builtin_amdgcn_mfma_f32_32x32x16_bf16(PAF(2),VFR(6),o[1],0,0,0), C1,4, BZ4(GB,P1,t,1,128)); \
    GAPB(o[0]=__builtin_amdgcn_mfma_f32_32x32x16_bf16(PAF(3),VFR(3),o[0],0,0,0), C1,8, BZ4(GB,P1,t,2,128)); \
    GAPB(o[1]=__builtin_amdgcn_mfma_f32_32x32x16_bf16(PAF(3),VFR(7),o[1],0,0,0), C1,12, BZ4(GB,P1,t,3,128)); \
    }while(0)
  int t=1;
  #undef CMASK
  #define CMASK(P0,P1,t) do{}while(0)
  for(;t+5<NT;t+=2){
    STEP(pB0,pB1,pA0,pA1,t,true,true,true,true);     WAIT_BAR(2); RESC(); ROT();
    STEP(pA0,pA1,pB0,pB1,t+1,true,true,true,true);   WAIT_BAR(2); RESC(); ROT();
  }
  #undef CMASK
  #define CMASK(P0,P1,t) do{int jb_=(t)-(NT-4); if(jb_>=0)cmask(P0,P1,jb_,qrel,hi);}while(0)
  #define ENDW(tt) do{ if((tt)+3<NT){WAIT_BAR(2);} else if((tt)+2<NT){WAIT_BAR(1);} else {WAIT_BAR(0);} }while(0)
  for(;t+2<NT;t+=2){
    STEP(pB0,pB1,pA0,pA1,t,(t+3<NT),(t+1<NT),(t+1<NT),true);       ENDW(t);   RESC(); ROT();
    STEP(pA0,pA1,pB0,pB1,t+1,(t+4<NT),(t+2<NT),(t+2<NT),true);     ENDW(t+1); RESC(); ROT();
  }
  STEP(pB0,pB1,pA0,pA1,NT-2,false,true,true,true); ENDW(NT-2); RESC(); ROT();
  STEP(pA0,pA1,pB0,pB1,NT-1,false,false,false,false); RESC();
  { float sacc=pA0[0]+pA0[1]; _Pragma("unroll") for(int r=2;r<16;++r)sacc+=pA0[r]; _Pragma("unroll") for(int r=0;r<16;++r)sacc+=pA1[r]; l_reg+=sacc;
    pw0=(u32x4){PKW(pA0,0),PKW(pA0,2),PKW(pA0,4),PKW(pA0,6)};pw1=(u32x4){PKW(pA0,8),PKW(pA0,10),PKW(pA0,12),PKW(pA0,14)};pw2=(u32x4){PKW(pA1,0),PKW(pA1,2),PKW(pA1,4),PKW(pA1,6)};pw3=(u32x4){PKW(pA1,8),PKW(pA1,10),PKW(pA1,12),PKW(pA1,14)};
    SBAR(); pv(o,vb0+sl_cur,PAF(0),PAF(1),PAF(2),PAF(3)); }
  #undef PKW
  #undef PAF
  #undef VFR
  #undef PIN
  #undef MX3
  #undef GAPA
  #undef GAPB
  #undef EX
  #undef VRD
  #undef KRD
  #undef STEP
  #undef ENDW
  {auto rr=__builtin_amdgcn_permlane32_swap(__float_as_uint(l_reg),__float_as_uint(l_reg),false,false);l_reg=__uint_as_float(rr[0])+__uint_as_float(rr[1]);}
  if(hi==0)wsf[32+r32]=l_reg;asm volatile("s_waitcnt lgkmcnt(0)":::"memory");
  float rli[16];
  #pragma unroll
  for(int r=0;r<16;++r)rli[r]=__builtin_amdgcn_rcpf(wsf[32+crow(r,hi)]);
  bf16*Ow=O+(rowbase+q0+wid*QBLK)*DM+h*D;
  { bf16*stg=(bf16*)(shm+LDS_OST)+wid*2048;
    #pragma unroll
    for(int r=0;r<16;++r){const int orow=crow(r,hi);
      #pragma unroll
      for(int d0=0;d0<2;++d0)stg[orow*64+d0*32+r32]=__float2bfloat16(o[d0][r]*rli[r]);}
    asm volatile("s_waitcnt lgkmcnt(0)":::"memory");
    #pragma unroll
    for(int i=0;i<4;++i){const int row=i*8+(lane>>3),ch=lane&7; const u32x4 v=*(const u32x4*)(stg+row*64+ch*8); ATTN_STORE16(Ow+(long)row*DM+ch*8,v);} }
  asm volatile("s_waitcnt lgkmcnt(0)\n\ts_barrier":::"memory");
  #undef DMA_K
  #undef BIAS4
  #undef BIAS16
  #undef BZ4
  #undef DMA_V
  #undef CMASK
  #undef START
  #undef RESC
  #undef ROT
}
constexpr int ATTN_LDS_BYTES=LDS_BYTES;
struct AttnTensors { const bf16* Q; const bf16* K; const bf16* V; bf16* O; const float* CB; };
struct AttnUnit { int bh; int qb; };
struct StaticOrder {
  int vcu;
  __device__ __forceinline__ explicit StaticOrder(int grid,int block):vcu((block%8)*(grid/8)+block/8){}
  __device__ __forceinline__ bool next(int i,AttnUnit&u)const{ if(i>=2||vcu>=256)return false; const int s=vcu&7; u.bh=vcu>>3; u.qb=(i==0)?15-s:s; return true; }
  __device__ __forceinline__ void a_ready(const AttnUnit&)const{}
  __device__ __forceinline__ void done(const AttnUnit&)const{}
};
template<class Sched,int THRL=8> __device__ __forceinline__ void attn_phase(char*lds,const AttnTensors&T,const Sched&S,const int wave_in){
  AttnUnit u;
  for(int i=0;S.next(i,u);++i){ S.a_ready(u); attn_unit<THRL>(u.bh/NHEAD,u.bh%NHEAD,u.qb,T.Q,T.K,T.V,T.O,T.CB+(size_t)u.bh*CBLEN,lds,wave_in); S.done(u); }
}
#undef SBAR
#undef WAIT_BAR
}

#define GAS __attribute__((address_space(1)))
#define LAS __attribute__((address_space(3)))
typedef unsigned short bf16;
typedef unsigned v4u __attribute__((ext_vector_type(4)));
typedef float f32x4 __attribute__((ext_vector_type(4)));
typedef short bf16x8 __attribute__((ext_vector_type(8)));
typedef GAS unsigned gu32;
typedef GAS unsigned long long gu64;
#define RLX_AGENT __ATOMIC_RELAXED, __HIP_MEMORY_SCOPE_AGENT
#define LDS_WAIT() asm volatile("s_waitcnt lgkmcnt(0)" ::: "memory")
#define VM_WAIT() asm volatile("s_waitcnt vmcnt(0)" ::: "memory")
__device__ __forceinline__ unsigned long long rt() { return __builtin_amdgcn_s_memrealtime(); }
__device__ __forceinline__ unsigned f2bf(float f) { unsigned u = __builtin_bit_cast(unsigned, f); return (u + 0x7fffu + ((u >> 16) & 1u)) >> 16; }
__device__ __forceinline__ unsigned pk2(float lo, float hi) { return f2bf(lo) | (f2bf(hi) << 16); }

#define XB_TMO      128
#define XB_XCNT(j)  (256  + 64 * (j))
#define XB_XSUB(j)  (1280 + 64 * (j))
#define XB_XGEN(j)  (2304 + 64 * (j))
#define XB_TOP      3328
#define XB_TOPGEN   3392
#define XCD_BAR_WORDS 3456
#define XB_SPIN_CAP (1u << 18)

__device__ __forceinline__ unsigned xb_ld(unsigned* p)              { return __hip_atomic_load(p, __ATOMIC_RELAXED, __HIP_MEMORY_SCOPE_AGENT); }
__device__ __forceinline__ unsigned xb_add(unsigned* p, unsigned v) { return __hip_atomic_fetch_add(p, v, __ATOMIC_RELAXED, __HIP_MEMORY_SCOPE_AGENT); }
__device__ __forceinline__ unsigned xb_xcc_id() { return (unsigned)__builtin_amdgcn_s_getreg((3 << 11) | 20) & 0xFu; }
#define XB_SPIN(cond, bar) do { unsigned _sp = 0; while (cond) { __builtin_amdgcn_s_sleep(1); \
    if ((++_sp & 255u) == 0u) { if (xb_ld(&(bar)[XB_TMO])) break; if (_sp > XB_SPIN_CAP) { atomicAdd(&(bar)[XB_TMO], 1u); break; } } } } while (0)

struct XcdBarrier {
    int wave; unsigned* bar; unsigned x;
    volatile LAS unsigned* st;
};

__device__ __forceinline__ XcdBarrier xcd_barrier_post(unsigned* bar, volatile LAS unsigned* st, int wave) {
    XcdBarrier b; b.wave = wave; b.bar = bar; b.x = xb_xcc_id(); b.st = st;
    if (mk_tid(wave) == 0) (void)xb_add(&bar[XB_XCNT(b.x)], 1u);
    return b;
}
__device__ __forceinline__ void xcd_barrier_complete(unsigned* bar, unsigned x, unsigned& nloc, unsigned& nx) {
    const unsigned G = gridDim.x * gridDim.y * gridDim.z;
    unsigned sum, cnt, mine, sp = 0u;
    for (;;) {
        sum = 0u; cnt = 0u; mine = 0u;
#pragma unroll
        for (unsigned j = 0; j < 16; ++j) { const unsigned c = xb_ld(&bar[XB_XCNT(j)]); sum += c; cnt += (c > 0u) ? 1u : 0u; mine = (j == x) ? c : mine; }
        if (sum == G) break;
        __builtin_amdgcn_s_sleep(1);
        if ((++sp & 255u) == 0u) { if (xb_ld(&bar[XB_TMO])) break; if (sp > XB_SPIN_CAP) { atomicAdd(&bar[XB_TMO], 1u); break; } }
    }
    nloc = mine > 0u ? mine : 1u; nx = cnt > 0u ? cnt : 1u;
}

__device__ __forceinline__ void xcd_barrier(const XcdBarrier& b) {
    asm volatile("s_waitcnt vmcnt(0)" ::: "memory");
    __syncthreads();
    if (mk_tid(b.wave) == 0) {
        unsigned* bar = b.bar;
        __builtin_amdgcn_s_waitcnt(0);
        unsigned nloc = b.st[0], nx = b.st[1];
        if (nloc == 0u) { xcd_barrier_complete(bar, b.x, nloc, nx); b.st[0] = nloc; b.st[1] = nx; }
        const unsigned old = xb_add(&bar[XB_XSUB(b.x)], 1u);
        const unsigned gen = old / nloc;
        if (old + 1u == (gen + 1u) * nloc) {
            __builtin_amdgcn_fence(__ATOMIC_RELEASE, "agent");
            asm volatile("s_waitcnt vmcnt(0)" ::: "memory");
            const unsigned og = xb_add(&bar[XB_TOP], 1u);
            const unsigned tg = og / nx;
            if (og + 1u == (tg + 1u) * nx) xb_add(&bar[XB_TOPGEN], 1u);
            else XB_SPIN(xb_ld(&bar[XB_TOPGEN]) == tg, bar);
            __builtin_amdgcn_fence(__ATOMIC_ACQUIRE, "agent");
            xb_add(&bar[XB_XGEN(b.x)], 1u);
            asm volatile("s_waitcnt vmcnt(0)" ::: "memory");
        } else {
            XB_SPIN(xb_ld(&bar[XB_XGEN(b.x)]) == gen, bar);
            __builtin_amdgcn_fence(__ATOMIC_ACQUIRE, "agent");
            asm volatile("s_waitcnt vmcnt(0)" ::: "memory");
        }
    }
    __syncthreads();
}

constexpr int NWAVES = 8;
constexpr int DM = 1024, NB = 4, SEQ = 4096, NMETA = 16, TP = NMETA + SEQ, DB = 32, PAST = 8192, PAGE = 128, NPG = PAST / PAGE;
constexpr int DATT = 512, DRNN = 512, HD = 64, NH = 8, DFF = 2816, DIN = 2568, NIN = 2560;
constexpr int M = NB * SEQ, MP = M + 256, ROW_META = M, ROW_SAMP = M + NMETA, NRV = M + NMETA + DB;
constexpr int ZF = 1536, ZXR = 1544;
constexpr float EPS = 1e-6f, LOG2E = 1.4426950408889634f;
constexpr int CBLEN = 64 + SEQ, NCHUNK = SEQ / 64, PREC = 68;
constexpr size_t O_Y = 0, O_YS = O_Y + (size_t)NB * SEQ * DM, O_KP = O_YS + (size_t)DB * DM, O_VP = O_KP + (size_t)NB * TP * DATT, O_FP = O_VP + (size_t)NB * TP * DATT,
    O_HP = O_FP + (size_t)NB * TP * NH, O_RCP = O_HP + (size_t)NB * DRNN, O_FCP = O_RCP + (size_t)NB * 3 * DRNN, O_KS = O_FCP + (size_t)NB * 2 * DFF, O_VS = O_KS + (size_t)DB * DATT,
    O_FS = O_VS + (size_t)DB * DATT, O_HS = O_FS + (size_t)DB * NH, O_RCS = O_HS + (size_t)DB * DRNN, O_FCS = O_RCS + (size_t)DB * 3 * DRNN, O_END = O_FCS + (size_t)DB * 2 * DFF;
constexpr size_t MiB = 1u << 20;
constexpr size_t WS_CTL = 0, CTL_ZERO_BYTES = 1 * MiB;
constexpr size_t WS_WIN = 2 * MiB, WS_WOUT = 7 * MiB, WS_WUP = 9 * MiB, WS_WDN = 20 * MiB, WS_WG = 26 * MiB, WS_CB = 27 * MiB, WS_AGG = 28 * MiB, WS_LOGF = 30 * MiB, WS_PART = 31 * MiB;
constexpr size_t WS_HN = 40 * MiB, WS_Q = 73 * MiB, WS_K = 90 * MiB, WS_V = 107 * MiB, WS_XR = 124 * MiB, WS_GR = 141 * MiB, WS_MG = 158 * MiB, WS_X1 = 191 * MiB;
constexpr size_t WS_G = 256 * MiB, WS_VAL = 346 * MiB, WS_ACT = 436 * MiB, WS_X2 = 526 * MiB, WS_END = 592 * MiB;
static_assert(WS_WIN + (size_t)NIN * DM * 2 <= WS_WOUT && WS_WUP + (size_t)2 * DFF * DM * 2 <= WS_WDN && WS_WDN + (size_t)DM * DFF * 2 <= WS_WG && WS_CB + (size_t)NB * NH * CBLEN * 4 <= WS_AGG, "ws map 1");
static_assert(WS_AGG + (size_t)NB * (NCHUNK + 1) * 2 * DRNN * 4 <= WS_LOGF && WS_LOGF + (size_t)MP * NH * 4 <= WS_PART && WS_PART + (size_t)DB * NPG * NH * PREC * 4 <= WS_HN, "ws map 2");
static_assert(WS_HN + (size_t)MP * DM * 2 <= WS_Q && WS_Q + (size_t)MP * 512 * 2 <= WS_K && WS_MG + (size_t)MP * DM * 2 <= WS_X1 && WS_X1 + (size_t)MP * DM * 4 <= WS_G, "ws map 3");
static_assert(WS_G + (size_t)MP * DFF * 2 <= WS_VAL && WS_VAL + (size_t)MP * DFF * 2 <= WS_ACT && WS_ACT + (size_t)MP * DFF * 2 <= WS_X2 && WS_X2 + (size_t)MP * DM * 4 <= WS_END, "ws map 4");
constexpr int CW_TMO = 0, CW_CODE = 1, CW_BAR = 4096;
constexpr int RING_OFF = 0, RING_BYTES = 131072, LDSCTL_OFF = RING_BYTES, MISC_OFF = LDSCTL_OFF + 320, LDS_BYTES = 147456;
static_assert(attn_body::ATTN_LDS_BYTES <= RING_BYTES, "attention LDS");

typedef float f32x16 __attribute__((ext_vector_type(16)));
typedef unsigned u32x2 __attribute__((ext_vector_type(2)));
typedef unsigned u32x4 __attribute__((ext_vector_type(4)));

struct Args { const float* in[29]; float* out; unsigned char* ws; int ph_lo, ph_hi; };
static_assert(sizeof(Args) == 29 * 8 + 8 + 8 + 8, "Args has no padding");

__device__ __forceinline__ float wave_sum(float v) {
#pragma unroll
    for (int o = 1; o < 64; o <<= 1) v += __shfl_xor(v, o);
    return v;
}
__device__ __forceinline__ float wave_max(float v) {
#pragma unroll
    for (int o = 1; o < 64; o <<= 1) v = fmaxf(v, __shfl_xor(v, o));
    return v;
}
__device__ __forceinline__ float bf2f(unsigned short h) { return __uint_as_float((unsigned)h << 16); }
__device__ __forceinline__ float bflo(unsigned w) { return __uint_as_float(w << 16); }
__device__ __forceinline__ float bfhi(unsigned w) { return __uint_as_float(w & 0xffff0000u); }
__device__ __forceinline__ float fast_exp2(float x) { return __builtin_amdgcn_exp2f(x); }
__device__ __forceinline__ float fast_exp(float x) { return __builtin_amdgcn_exp2f(x * LOG2E); }
__device__ __forceinline__ float fast_rcp(float x) { return __builtin_amdgcn_rcpf(x); }
__device__ __forceinline__ float sigm(float x) { return fast_rcp(1.f + fast_exp(-x)); }
__device__ __forceinline__ float gelu_t(float x) { const float u = 1.5957691216057308f * (x + 0.044715f * x * x * x); return x * sigm(u); }
__device__ __forceinline__ float log_sigmoid_f(float z) { return fminf(z, 0.f) - log1pf(expf(-fabsf(z))); }
__device__ __forceinline__ float softplus_f(float z) { return fmaxf(z, 0.f) + log1pf(expf(-fabsf(z))); }
__device__ __forceinline__ float neg_expm1(float x) {
    const float p = x * (1.f + x * (0.5f + x * (0.16666667f + x * (0.041666668f + x * (0.0083333338f + x * 0.0013888889f)))));
    return x > -0.25f ? -p : 1.f - fast_exp(x);
}
__device__ __forceinline__ const float* xrow_ptr(const float* xp, const float* xs, const float* meta, int r) {
    return r < M ? xp + (size_t)r * DM : (r < ROW_SAMP ? meta + (size_t)(r - ROW_META) * DM : xs + (size_t)(r - ROW_SAMP) * DM);
}

namespace pg8 {
struct EpiInProj {
    static constexpr bool PERM = true, AFTER_DRAIN = false;
    bf16_t* dst0; size_t dstride; float* out; float c2;
    __device__ __forceinline__ void operator()(const f32x4 (&acc)[2][2][4][2], const Unit& u, int wr, int wc, int fr, int fq) const {
        const int t = u.pn >> 1, row0 = u.pm * BM + wr * 64 + fr, col0 = (u.pn & 1) * 256 + wc * 32 + 8 * fq;
        bf16_t* base = dst0 + (size_t)t * dstride; const float sc = t == 0 ? c2 : 1.f;
        float* ob = (t == 1) ? out + O_KP : out + O_VP; const bool f32o = (t == 1 || t == 2);
#pragma unroll
        for (int ai = 0; ai < 2; ++ai)
#pragma unroll
            for (int m = 0; m < 4; ++m) { const int row = row0 + ai * HALF + m * 16; bf16_t* rowp = base + (size_t)row * 512 + col0;
                float* orow = ob + ((size_t)(row >> 12) * TP + NMETA + (row & (SEQ - 1))) * DATT + col0;
#pragma unroll
                for (int bj = 0; bj < 2; ++bj) { f32x4 v0 = acc[ai][bj][m][0], v1 = acc[ai][bj][m][1];
                    if (f32o) { *(f32x4*)(orow + bj * HALF) = v0; *(f32x4*)(orow + bj * HALF + 4) = v1; }
                    v0 = v0 * sc; v1 = v1 * sc; u32x4 w; w.x = cvt_pk_bf16(v0[0], v0[1]); w.y = cvt_pk_bf16(v0[2], v0[3]); w.z = cvt_pk_bf16(v1[0], v1[1]); w.w = cvt_pk_bf16(v1[2], v1[3]);
                    *(u32x4*)(rowp + bj * HALF) = w; } }
    }
};
struct EpiAddF32 {
    static constexpr bool PERM = false, AFTER_DRAIN = false;
    const float* base; float* out; int ldc;
    __device__ __forceinline__ void operator()(const f32x4 (&acc)[2][2][4][2], const Unit& u, int wr, int wc, int fr, int fq) const {
        const int row0 = u.pm * BM + wr * 64 + fr, col0 = u.pn * BM + wc * 32 + 4 * fq;
#pragma unroll
        for (int ai = 0; ai < 2; ++ai)
#pragma unroll
            for (int m = 0; m < 4; ++m) { const size_t off = (size_t)(row0 + ai * HALF + m * 16) * ldc + col0;
#pragma unroll
                for (int bj = 0; bj < 2; ++bj)
#pragma unroll
                    for (int n = 0; n < 2; ++n) { const f32x4 b = *(const f32x4*)(base + off + bj * HALF + n * 16); *(f32x4*)(out + off + bj * HALF + n * 16) = b + acc[ai][bj][m][n]; } }
    }
};
}

template <class F> __device__ __forceinline__ void side_gemm_job(LAS unsigned char* lds, const bf16* A, const bf16* Wt, int K, int ct, const F& f, const int wave_in) {
    const int tid = mk_tid(wave_in), lane = tid & 63, wid = wave_in, ml = lane & 31, kh = lane >> 5;
    const int kw = K / 8, k0 = wid * kw;
    f32x16 acc0 = {}, acc1 = {};
    const bf16* a0 = A + (size_t)ml * K + k0 + 8 * kh; const bf16* a1 = a0 + (size_t)32 * K; const bf16* bp = Wt + (size_t)(ct * 32 + ml) * K + k0 + 8 * kh;
#pragma unroll 2
    for (int ks = 0; ks < kw / 16; ++ks) {
        const bf16x8 fa0 = *(const bf16x8*)(a0 + 16 * ks), fa1 = *(const bf16x8*)(a1 + 16 * ks), fb = *(const bf16x8*)(bp + 16 * ks);
        acc0 = __builtin_amdgcn_mfma_f32_32x32x16_bf16(fa0, fb, acc0, 0, 0, 0); acc1 = __builtin_amdgcn_mfma_f32_32x32x16_bf16(fa1, fb, acc1, 0, 0, 0);
    }
    LAS float* red = (LAS float*)lds;
#pragma unroll
    for (int r = 0; r < 16; ++r) { red[((wid * 2 + 0) * 16 + r) * 64 + lane] = acc0[r]; red[((wid * 2 + 1) * 16 + r) * 64 + lane] = acc1[r]; }
    __syncthreads();
#pragma unroll
    for (int q = 0; q < 4; ++q) { const int idx = tid + 512 * q, rt = idx >> 10, r = (idx >> 6) & 15, ln = idx & 63; float s = 0.f;
#pragma unroll
        for (int w = 0; w < 8; ++w) s += red[((w * 2 + rt) * 16 + r) * 64 + ln];
        f(rt * 32 + (r & 3) + 8 * (r >> 2) + 4 * (ln >> 5), ct * 32 + (ln & 31), s); }
    __syncthreads();
}

__device__ __forceinline__ void p0_transpose_item(const float* W, int ldw, int K, int nblk, bf16* WT, LAS float* scr, int item, int lane) {
    const int kb = item / nblk, nb = item % nblk, k0 = 64 * kb, n0 = 32 * nb;
#pragma unroll 8
    for (int i = 0; i < 32; ++i) { const int kk = 2 * i + (lane >> 5); scr[kk * 33 + (lane & 31)] = W[(size_t)(k0 + kk) * ldw + n0 + (lane & 31)]; }
    LDS_WAIT(); asm volatile("" ::: "memory");
    const int c = lane & 7;
#pragma unroll
    for (int j = 0; j < 4; ++j) { const int n = (lane >> 3) + 8 * j; const LAS float* s = scr + (8 * c) * 33 + n;
        v4u o; o.x = pk2(s[0 * 33], s[1 * 33]); o.y = pk2(s[2 * 33], s[3 * 33]); o.z = pk2(s[4 * 33], s[5 * 33]); o.w = pk2(s[6 * 33], s[7 * 33]);
        *(GAS v4u*)(WT + (size_t)(n0 + n) * K + k0 + 8 * c) = o; }
    LDS_WAIT(); asm volatile("" ::: "memory");
}
struct P0Args { const float *xp, *xs, *meta, *nmix, *win, *bfor, *wa, *wx, *wout, *wup, *wdn; bf16 *WIN, *WOUT, *WUP, *WDN, *WG, *HN; float *LOGF, *out; };
__device__ __forceinline__ void p0_prologue(LAS unsigned char* lds, const P0Args& P, int vcu, int G, const int wave) {
    const int tid = mk_tid(wave), lane = tid & 63;
    LAS float* scr = (LAS float*)(lds + wave * 8704);
    LAS float* wf = (LAS float*)(lds + 73728);
    for (int i = tid; i < DM * 2; i += NWAVES * 64) { const int k = i >> 1, hh = i & 1; *(LAS f32x4*)(wf + k * 8 + hh * 4) = *(const f32x4*)(P.win + (size_t)k * DIN + ZF + hh * 4); }
    __syncthreads();
    const int gw = vcu * NWAVES + wave, NGW = G * NWAVES;
    for (int r = gw; r < NRV + 16; r += NGW) {
        GAS unsigned long long* o8 = (GAS unsigned long long*)(P.HN + (size_t)r * DM) + lane;
        if (r >= NRV) {
#pragma unroll
            for (int j = 0; j < 4; ++j) o8[64 * j] = 0ull;
            continue; }
        const GAS f32x4* xr = (const GAS f32x4*)xrow_ptr(P.xp, P.xs, P.meta, r) + lane;
        f32x4 v[4]; float s = 0.f;
#pragma unroll
        for (int j = 0; j < 4; ++j) { v[j] = xr[64 * j]; s += (v[j].x * v[j].x + v[j].y * v[j].y) + (v[j].z * v[j].z + v[j].w * v[j].w); }
        const float rstd = rsqrtf(wave_sum(s) * (1.f / DM) + EPS);
        float fa[8] = {0.f, 0.f, 0.f, 0.f, 0.f, 0.f, 0.f, 0.f};
#pragma unroll
        for (int j = 0; j < 4; ++j) { const f32x4 g = *((const GAS f32x4*)P.nmix + 64 * j + lane); v[j] = v[j] * rstd * g;
            o8[64 * j] = (unsigned long long)pk2(v[j].x, v[j].y) | ((unsigned long long)pk2(v[j].z, v[j].w) << 32);
#pragma unroll
            for (int e = 0; e < 4; ++e) { const int k = 4 * (64 * j + lane) + e; const f32x4 w0 = *(const LAS f32x4*)(wf + k * 8), w1 = *(const LAS f32x4*)(wf + k * 8 + 4); const float hv = v[j][e];
                fa[0] += hv * w0.x; fa[1] += hv * w0.y; fa[2] += hv * w0.z; fa[3] += hv * w0.w; fa[4] += hv * w1.x; fa[5] += hv * w1.y; fa[6] += hv * w1.z; fa[7] += hv * w1.w; } }
        float mine = 0.f;
#pragma unroll
        for (int e = 0; e < 8; ++e) { const float t = wave_sum(fa[e]); if (lane == e) mine = t; }
        if (lane < NH) { const float lf = log_sigmoid_f(mine + P.bfor[lane]); P.LOGF[(size_t)r * NH + lane] = lf;
            if (r < M) P.out[O_FP + ((size_t)(r >> 12) * TP + NMETA + (r & (SEQ - 1))) * NH + lane] = lf;
            else if (r < ROW_SAMP) { for (int b = 0; b < NB; ++b) P.out[O_FP + ((size_t)b * TP + (r - ROW_META)) * NH + lane] = lf; }
            else P.out[O_FS + (size_t)(r - ROW_SAMP) * NH + lane] = lf; }
    }
    constexpr int I_IN1 = 16 * 48, I_IN2 = 16 * 32, I_OUT = 16 * 32, I_UP = 16 * 176, I_DN = 44 * 32, I_G = 32, NITEMS = I_IN1 + I_IN2 + I_OUT + I_UP + I_DN + I_G;
    for (int it = gw; it < NITEMS; it += NGW) {
        int r = it;
        if (r < I_IN1) { p0_transpose_item(P.win, DIN, DM, 48, P.WIN, scr, r, lane); continue; } r -= I_IN1;
        if (r < I_IN2) { p0_transpose_item(P.win + ZXR, DIN, DM, 32, P.WIN + (size_t)1536 * DM, scr, r, lane); continue; } r -= I_IN2;
        if (r < I_OUT) { p0_transpose_item(P.wout, DM, DM, 32, P.WOUT, scr, r, lane); continue; } r -= I_OUT;
        if (r < I_UP) { p0_transpose_item(P.wup, 2 * DFF, DM, 176, P.WUP, scr, r, lane); continue; } r -= I_UP;
        if (r < I_DN) { p0_transpose_item(P.wdn, DM, DFF, 32, P.WDN, scr, r, lane); continue; } r -= I_DN;
        { const int gb = r >> 1, nbk = r & 1; const float* W = (gb < 8 ? P.wa : P.wx) + (size_t)(gb & 7) * 4096;
          p0_transpose_item(W, 64, 64, 2, P.WG + (size_t)gb * 4096, scr, nbk, lane); }
    }
}

__device__ __forceinline__ void cb_job(LAS unsigned char* lds, const float* LOGF, float* CB, int bh, const int wave_in) {
    const int tid = mk_tid(wave_in), lane = tid & 63, wid = wave_in, b = bh >> 3, h = bh & 7;
    LAS float* wt = (LAS float*)lds;
    float cm = 0.f, cmeta_mine = 0.f;
    for (int p = 0; p < NMETA; ++p) { cm += LOGF[(size_t)(ROW_META + p) * NH + h]; if (p == tid) cmeta_mine = cm; }
    float v[8]; float s = 0.f;
#pragma unroll
    for (int j = 0; j < 8; ++j) { s += LOGF[((size_t)b * SEQ + 8 * tid + j) * NH + h]; v[j] = s; }
    float inc = s;
#pragma unroll
    for (int o = 1; o < 64; o <<= 1) { const float t = __shfl_up(inc, o); if (lane >= o) inc += t; }
    if (lane == 63) wt[wid] = inc;
    __syncthreads();
    float base = cm + (inc - s);
    for (int w = 0; w < wid; ++w) base += wt[w];
    float* cb = CB + (size_t)bh * CBLEN;
#pragma unroll
    for (int j = 0; j < 8; ++j) cb[64 + 8 * tid + j] = -LOG2E * (base + v[j]);
    if (tid < NMETA) cb[tid] = -LOG2E * cmeta_mine; else if (tid < 64) cb[tid] = -1e30f;
    __syncthreads();
}
constexpr int RL_CW = 0, RL_CB = 2048, RL_BA = 2560, RL_BX = 3072, RL_SP = 3584, RL_GN = 4096, RL_SQ = 4608, RL_CAR = 5120, RL_YST = 6144, RL_FLOATS = RL_YST + 8 * 2048;
struct RnnArgs { const bf16 *XR, *GR, *WG; const float *cw, *cb, *ba, *bx, *lam, *gn, *sconv, *h0s; float *AGG; bf16* MG; float* out; };
__device__ __forceinline__ void rnn_stage_params(LAS unsigned char* lds, const RnnArgs& R, const int wave_in) {
    LAS float* L = (LAS float*)lds; const int c = mk_tid(wave_in);
#pragma unroll
    for (int j = 0; j < 4; ++j) L[RL_CW + j * 512 + c] = R.cw[j * 512 + c];
    L[RL_CB + c] = R.cb[c]; L[RL_BA + c] = R.ba[c]; L[RL_BX + c] = R.bx[c]; L[RL_SP + c] = 8.0f * softplus_f(-R.lam[c]); L[RL_GN + c] = R.gn[c];
    __syncthreads();
}
#define DPP_F(OLD, SRC, CTRL, RM) __int_as_float(__builtin_amdgcn_update_dpp(__float_as_int(OLD), __float_as_int(SRC), CTRL, RM, 0xf, false))
#define RNN_SCAN_STEP(CTRL, RM) do { _Pragma("unroll") for (int r = 0; r < 16; ++r) { const float as_ = DPP_F(1.f, a[r], CTRL, RM), us_ = DPP_F(0.f, u[r], CTRL, RM); u[r] = a[r] * us_ + u[r]; a[r] = a[r] * as_; } __builtin_amdgcn_sched_barrier(0); } while (0)
template <int PASS> __device__ __forceinline__ void rnn_unit(LAS unsigned char* lds, const RnnArgs& R, int kind, int b, int k, const int wave_in) {
    const int lane0 = mk_lane(), wid = wave_in, cbase = 64 * wid;
    const LAS float* L = (const LAS float*)lds; LAS float* SQ = (LAS float*)lds + RL_SQ;
    if (PASS == 2 && kind != 2) {
        const int tl = lane0 & 31, hi = lane0 >> 5; LAS float* car = (LAS float*)lds + RL_CAR + wid * 128 + hi * 64;
        float cU[2][16];
#pragma unroll
        for (int mb = 0; mb < 2; ++mb)
#pragma unroll
            for (int r = 0; r < 16; ++r) cU[mb][r] = 0.f;
        if (kind == 0) {
#pragma unroll 1
            for (int kk = 0; kk <= k; ++kk) { const float* ag = R.AGG + ((size_t)(b * (NCHUNK + 1) + kk) * 2) * DRNN + cbase + 8 * hi;
#pragma unroll
                for (int mb = 0; mb < 2; ++mb)
#pragma unroll
                    for (int g = 0; g < 4; ++g) { const f32x4 A4 = *(const f32x4*)(ag + 16 * g + 4 * mb), U4 = *(const f32x4*)(ag + DRNN + 16 * g + 4 * mb);
#pragma unroll
                        for (int i = 0; i < 4; ++i) cU[mb][4 * g + i] = A4[i] * cU[mb][4 * g + i] + U4[i]; } }
        }
        if (tl == 0) {
#pragma unroll
            for (int mb = 0; mb < 2; ++mb)
#pragma unroll
                for (int g = 0; g < 4; ++g) *(LAS f32x4*)(car + mb * 16 + 4 * g) = (f32x4){cU[mb][4 * g], cU[mb][4 * g + 1], cU[mb][4 * g + 2], cU[mb][4 * g + 3]};
        }
    }
    const int ntile = kind == 0 ? 2 : 1;
#pragma unroll 1
    for (int tb = 0; tb < ntile; ++tb) {
        const bf16* XRp = R.XR; const bf16* GRp = R.GR; const bf16* WGp = R.WG; bf16* MGp = R.MG; float* outp = R.out; float* AGGp = R.AGG; const float* sconvp = R.sconv; const float* h0p = R.h0s;
        asm volatile("" : "+s"(XRp), "+s"(GRp), "+s"(WGp), "+s"(MGp), "+s"(outp), "+s"(AGGp), "+s"(sconvp), "+s"(h0p));
        int lanev = lane0; asm volatile("" : "+v"(lanev));
        const int tl = lanev & 31, hi = lanev >> 5, dd = 16 * (tl >> 3) + 8 * ((tl >> 2) & 1) + (tl & 3);
        LAS float* car = (LAS float*)lds + RL_CAR + wid * 128 + hi * 64;
        LAS float* yst = (LAS float*)lds + RL_YST + wid * 2048 + lanev;
        asm volatile("" ::: "memory");
        const bool valid = kind == 1 ? tl < NMETA : true;
        const int t = 64 * k + 32 * tb + tl;
        const int row = kind == 0 ? b * SEQ + t : (kind == 1 ? ROW_META + tl : ROW_SAMP + tl);
        float xc[4][8];
#pragma unroll
        for (int ks = 0; ks < 4; ++ks) { const int c0 = cbase + 16 * ks + 8 * hi;
            const f32x4 b0 = *(const LAS f32x4*)(L + RL_CB + c0), b1 = *(const LAS f32x4*)(L + RL_CB + c0 + 4);
#pragma unroll
            for (int j = 0; j < 4; ++j) { xc[ks][j] = b0[j]; xc[ks][4 + j] = b1[j]; } }
#pragma unroll
        for (int jj = 0; jj < 4; ++jj) {
            asm volatile("" ::: "memory"); __builtin_amdgcn_sched_barrier(0);
            const int dt = jj - 3; bool have = valid; const bf16* src = nullptr; const float* srcf = nullptr;
            if (kind == 0) { const int tt = t + dt; src = XRp + (size_t)(tt >= 0 ? b * SEQ + tt : ROW_META + NMETA + tt) * 512; }
            else if (kind == 1) { const int pp = tl + dt; have = valid && pp >= 0; src = XRp + (size_t)(ROW_META + (pp >= 0 ? pp : 0)) * 512; }
            else { if (jj < 3) srcf = sconvp + ((size_t)tl * 3 + jj) * DRNN; else src = XRp + (size_t)(ROW_SAMP + tl) * 512; }
#pragma unroll
            for (int ks = 0; ks < 4; ++ks) { const int c0 = cbase + 16 * ks + 8 * hi; float xv[8];
                if (srcf) { const f32x4 q0 = *(const f32x4*)(srcf + c0), q1 = *(const f32x4*)(srcf + c0 + 4);
#pragma unroll
                    for (int j = 0; j < 4; ++j) { xv[j] = q0[j]; xv[4 + j] = q1[j]; } }
                else { u32x4 w = {0u, 0u, 0u, 0u}; if (have) w = *(const u32x4*)(src + c0);
                    xv[0] = bflo(w.x); xv[1] = bfhi(w.x); xv[2] = bflo(w.y); xv[3] = bfhi(w.y); xv[4] = bflo(w.z); xv[5] = bfhi(w.z); xv[6] = bflo(w.w); xv[7] = bfhi(w.w); }
                const f32x4 w0 = *(const LAS f32x4*)(L + RL_CW + jj * 512 + c0), w1 = *(const LAS f32x4*)(L + RL_CW + jj * 512 + c0 + 4);
#pragma unroll
                for (int j = 0; j < 4; ++j) { xc[ks][j] += w0[j] * xv[j]; xc[ks][4 + j] += w1[j] * xv[4 + j]; }
                asm volatile("" : "+v"(xc[ks][0]), "+v"(xc[ks][1]), "+v"(xc[ks][2]), "+v"(xc[ks][3]), "+v"(xc[ks][4]), "+v"(xc[ks][5]), "+v"(xc[ks][6]), "+v"(xc[ks][7]));
                if (PASS == 2) {
                    if (jj == 3 && kind == 0 && k == NCHUNK - 1 && tb == 1 && tl >= 29) { float* o = outp + O_RCP + ((size_t)b * 3 + (tl - 29)) * DRNN + c0;
                        *(f32x4*)o = (f32x4){xv[0], xv[1], xv[2], xv[3]}; *(f32x4*)(o + 4) = (f32x4){xv[4], xv[5], xv[6], xv[7]}; }
                    if (kind == 2 && jj >= 1) { float* o = outp + O_RCS + ((size_t)tl * 3 + (jj - 1)) * DRNN + c0;
                        *(f32x4*)o = (f32x4){xv[0], xv[1], xv[2], xv[3]}; *(f32x4*)(o + 4) = (f32x4){xv[4], xv[5], xv[6], xv[7]}; }
                }
            }
        }
        bf16x8 bfr[4];
#pragma unroll
        for (int ks = 0; ks < 4; ++ks) { u32x4 w; w.x = pk2(xc[ks][0], xc[ks][1]); w.y = pk2(xc[ks][2], xc[ks][3]); w.z = pk2(xc[ks][4], xc[ks][5]); w.w = pk2(xc[ks][6], xc[ks][7]); bfr[ks] = __builtin_bit_cast(bf16x8, w); }
        float ssq = 0.f;
#pragma unroll
        for (int mb = 0; mb < 2; ++mb) {
            asm volatile("" ::: "memory"); __builtin_amdgcn_sched_barrier(0);
            f32x16 Da = {}, Dx = {};
#pragma unroll
            for (int ks = 0; ks < 4; ++ks) {
                const bf16x8 wA = *(const bf16x8*)(WGp + ((size_t)(0 * 8 + wid) * 64 + dd + 4 * mb) * 64 + 16 * ks + 8 * hi), wX = *(const bf16x8*)(WGp + ((size_t)(1 * 8 + wid) * 64 + dd + 4 * mb) * 64 + 16 * ks + 8 * hi);
                Da = __builtin_amdgcn_mfma_f32_32x32x16_bf16(wA, bfr[ks], Da, 0, 0, 0); Dx = __builtin_amdgcn_mfma_f32_32x32x16_bf16(wX, bfr[ks], Dx, 0, 0, 0); }
            float a[16], u[16];
#pragma unroll
            for (int g = 0; g < 4; ++g) { const int c0 = cbase + 16 * g + 8 * hi + 4 * mb;
                asm volatile("" ::: "memory");
                const f32x4 ba4 = *(const LAS f32x4*)(L + RL_BA + c0), bx4 = *(const LAS f32x4*)(L + RL_BX + c0), sp4 = *(const LAS f32x4*)(L + RL_SP + c0);
#pragma unroll
                for (int i = 0; i < 4; ++i) { const int r = 4 * g + i; const float rr = sigm(Da[r] + ba4[i]), ii = sigm(Dx[r] + bx4[i]), la = -rr * sp4[i];
                    const float av = fast_exp(la), uv = sqrtf(neg_expm1(2.f * la)) * (ii * xc[g][4 * mb + i]);
                    a[r] = valid ? av : 1.f; u[r] = valid ? uv : 0.f; }
                __builtin_amdgcn_sched_barrier(0); }
            if (kind != 2) {
                RNN_SCAN_STEP(0x111, 0xf); RNN_SCAN_STEP(0x112, 0xf); RNN_SCAN_STEP(0x114, 0xf); RNN_SCAN_STEP(0x118, 0xf); RNN_SCAN_STEP(0x142, 0xa);
            }
            asm volatile("" ::: "memory");
            if (PASS == 1) {
                if (tl == 31) {
#pragma unroll
                    for (int g = 0; g < 4; ++g) { f32x4 A4 = {a[4 * g], a[4 * g + 1], a[4 * g + 2], a[4 * g + 3]}, U4 = {u[4 * g], u[4 * g + 1], u[4 * g + 2], u[4 * g + 3]};
                        if (tb == 1) { const f32x4 A0 = *(const LAS f32x4*)(car + mb * 16 + 4 * g), U0 = *(const LAS f32x4*)(car + 32 + mb * 16 + 4 * g); U4 = A4 * U0 + U4; A4 = A4 * A0; }
                        if (tb == ntile - 1) {
                            for (int bb = (kind == 1 ? 0 : b); bb < (kind == 1 ? NB : b + 1); ++bb) { float* ag = AGGp + ((size_t)(bb * (NCHUNK + 1) + (kind == 1 ? 0 : 1 + k)) * 2) * DRNN + cbase + 8 * hi + 16 * g + 4 * mb;
                                *(f32x4*)ag = A4; *(f32x4*)(ag + DRNN) = U4; } }
                        else { *(LAS f32x4*)(car + mb * 16 + 4 * g) = A4; *(LAS f32x4*)(car + 32 + mb * 16 + 4 * g) = U4; } }
                }
            } else {
#pragma unroll
                for (int g = 0; g < 4; ++g) { const int c0 = cbase + 16 * g + 8 * hi + 4 * mb;
                    asm volatile("" ::: "memory");
                    u32x2 gw = {0u, 0u}; if (valid) gw = *(const u32x2*)(GRp + (size_t)row * 512 + c0);
                    const float gr[4] = {bflo(gw.x), bfhi(gw.x), bflo(gw.y), bfhi(gw.y)};
                    f32x4 hin; if (kind == 2) hin = *(const f32x4*)(h0p + (size_t)tl * DRNN + c0); else hin = *(const LAS f32x4*)(car + mb * 16 + 4 * g);
                    f32x4 h4;
#pragma unroll
                    for (int i = 0; i < 4; ++i) { const int r = 4 * g + i; const float h = a[r] * hin[i] + u[r]; h4[i] = h;
                        const float yv = valid ? h * gelu_t(gr[i]) : 0.f; yst[(mb * 16 + r) * 64] = yv; ssq += yv * yv; }
                    if (kind == 2) *(f32x4*)(outp + O_HS + (size_t)tl * DRNN + c0) = h4;
                    if (kind == 0 && k == NCHUNK - 1 && tb == 1 && tl == 31) *(f32x4*)(outp + O_HP + (size_t)b * DRNN + c0) = h4;
                    asm volatile("s_waitcnt lgkmcnt(0)" ::: "memory");
                    if (tl == 31) *(LAS f32x4*)(car + mb * 16 + 4 * g) = h4;
                    __builtin_amdgcn_sched_barrier(0); }
            }
        }
        if (PASS == 2) {
            ssq += __shfl_xor(ssq, 32);
            if (hi == 0) SQ[(tb * 8 + wid) * 32 + tl] = ssq;
            __syncthreads();
            float tot = 0.f;
#pragma unroll
            for (int w = 0; w < 8; ++w) tot += SQ[(tb * 8 + w) * 32 + tl];
            const float rstd = rsqrtf(tot * (1.f / DRNN) + EPS);
            if (valid) {
#pragma unroll
                for (int g = 0; g < 4; ++g) { const int c0 = cbase + 16 * g + 8 * hi;
                    const f32x4 n0 = *(const LAS f32x4*)(L + RL_GN + c0), n1 = *(const LAS f32x4*)(L + RL_GN + c0 + 4);
                    float y0[4], y1[4];
#pragma unroll
                    for (int i = 0; i < 4; ++i) { y0[i] = yst[(4 * g + i) * 64] * rstd * n0[i]; y1[i] = yst[(16 + 4 * g + i) * 64] * rstd * n1[i]; }
                    u32x4 w; w.x = pk2(y0[0], y0[1]); w.y = pk2(y0[2], y0[3]); w.z = pk2(y1[0], y1[1]); w.w = pk2(y1[2], y1[3]);
                    *(u32x4*)(MGp + (size_t)row * DM + DATT + c0) = w; }
            }
        }
    }
}

struct DecArgs { const float *ck, *cv, *cf; const int* pt; const bf16* Q; float* PART; };
__device__ __forceinline__ float grp16_sum(float v) {
    v += __shfl_xor(v, 1); v += __shfl_xor(v, 2); v += __shfl_xor(v, 4); v += __shfl_xor(v, 8); return v;
}
__device__ __forceinline__ void decode_page_wave(LAS unsigned char* ldsw  , const DecArgs& Dd, int b, int pg) {
    const int lane = mk_lane(), g = lane >> 4, dl = lane & 15;
    const size_t page = (size_t)Dd.pt[b * NPG + pg];
    const float* Kp = Dd.ck + page * (size_t)(PAGE * NH * HD) + lane * 4; const float* Vp = Dd.cv + page * (size_t)(PAGE * NH * HD) + lane * 4; const float* Fp = Dd.cf + page * (size_t)(PAGE * NH);
    LAS float* fl = (LAS float*)ldsw;
#pragma unroll
    for (int i = 0; i < 4; ++i) *(LAS f32x4*)(fl + 4 * (lane + 64 * i)) = *(const f32x4*)(Fp + 4 * (lane + 64 * i));
    f32x4 qa, qb;
    { const u32x2 w0 = *(const u32x2*)(Dd.Q + (size_t)(ROW_SAMP + b) * 512 + g * 64 + 4 * dl), w1 = *(const u32x2*)(Dd.Q + (size_t)(ROW_SAMP + b) * 512 + (g + 4) * 64 + 4 * dl);
      qa = (f32x4){bflo(w0.x), bfhi(w0.x), bflo(w0.y), bfhi(w0.y)}; qb = (f32x4){bflo(w1.x), bfhi(w1.x), bflo(w1.y), bfhi(w1.y)}; }
    LDS_WAIT();
    float totA = 0.f, totB = 0.f;
#pragma unroll 4
    for (int j = 0; j < PAGE; ++j) { totA += fl[j * 8 + g]; totB += fl[j * 8 + g + 4]; }
    float prefA = 0.f, prefB = 0.f, mA = -INFINITY, mB = -INFINITY, lA = 0.f, lB = 0.f; f32x4 oA = {0.f, 0.f, 0.f, 0.f}, oB = {0.f, 0.f, 0.f, 0.f};
    f32x4 kc[4], vc[4], kn[4], vn[4];
#pragma unroll
    for (int i = 0; i < 4; ++i) { kn[i] = *(const f32x4*)(Kp + (size_t)i * 256); vn[i] = *(const f32x4*)(Vp + (size_t)i * 256); }
#pragma unroll 1
    for (int kg = 0; kg < PAGE / 2; ++kg) {
#pragma unroll
        for (int i = 0; i < 4; ++i) { kc[i] = kn[i]; vc[i] = vn[i]; }
        if (kg + 1 < PAGE / 2) {
#pragma unroll
            for (int i = 0; i < 4; ++i) { kn[i] = *(const f32x4*)(Kp + (size_t)((kg + 1) * 4 + i) * 256); vn[i] = *(const f32x4*)(Vp + (size_t)((kg + 1) * 4 + i) * 256); } }
#pragma unroll
        for (int jj = 0; jj < 2; ++jj) { const int j = 2 * kg + jj;
            { const f32x4 kk = kc[2 * jj]; float s = grp16_sum((kk.x * qa.x + kk.y * qa.y) + (kk.z * qa.z + kk.w * qa.w));
              prefA += fl[j * 8 + g]; s += (totA - prefA) * LOG2E;
              const float mn = fmaxf(mA, s), al = fast_exp2(mA - mn), p = fast_exp2(s - mn); mA = mn; lA = lA * al + p; oA = oA * al + vc[2 * jj] * p; }
            { const f32x4 kk = kc[2 * jj + 1]; float s = grp16_sum((kk.x * qb.x + kk.y * qb.y) + (kk.z * qb.z + kk.w * qb.w));
              prefB += fl[j * 8 + g + 4]; s += (totB - prefB) * LOG2E;
              const float mn = fmaxf(mB, s), al = fast_exp2(mB - mn), p = fast_exp2(s - mn); mB = mn; lB = lB * al + p; oB = oB * al + vc[2 * jj + 1] * p; } }
    }
    float* rec = Dd.PART + ((size_t)(b * NPG + pg) * NH + g) * PREC;
    *(f32x4*)(rec + 4 * dl) = oA; *(f32x4*)(rec + 4 * PREC + 4 * dl) = oB;
    if (dl == 0) { rec[64] = mA; rec[65] = lA; rec[66] = totA; rec[4 * PREC + 64] = mB; rec[4 * PREC + 65] = lB; rec[4 * PREC + 66] = totB; }
}
__device__ __forceinline__ void decode_combine_row(const float* PART, const float* LOGF, const bf16* Q, const bf16* K, const bf16* V, const float* gatt, bf16* MG, int b) {
    const int lane = mk_lane(); const size_t row = ROW_SAMP + b;
    float att[NH]; float ssq = 0.f;
#pragma unroll
    for (int h = 0; h < NH; ++h) {
        const float* rec = PART + ((size_t)(b * NPG + lane) * NH + h) * PREC;
        const float m_p = rec[64], l_p = rec[65], F_p = rec[66];
        float inc = F_p;
#pragma unroll
        for (int o = 1; o < 64; o <<= 1) { const float t = __shfl_up(inc, o); if (lane >= o) inc += t; }
        const float totalF = __shfl(inc, 63), G_p = LOGF[row * NH + h] + (totalF - inc);
        const float e_p = m_p + G_p * LOG2E;
        const float s_self = wave_sum(bf2f(Q[row * 512 + h * 64 + lane]) * bf2f(K[row * 512 + h * 64 + lane]));
        const float mx = fmaxf(wave_max(e_p), s_self), w_p = fast_exp2(e_p - mx), w_self = fast_exp2(s_self - mx);
        const float Lsum = wave_sum(w_p * l_p) + w_self;
        float o = w_self * bf2f(V[row * 512 + h * 64 + lane]);
        for (int p = 0; p < NPG; ++p) o += __shfl(w_p, p) * PART[((size_t)(b * NPG + p) * NH + h) * PREC + lane];
        att[h] = o / Lsum; ssq += att[h] * att[h];
    }
    const float rstd = rsqrtf(wave_sum(ssq) * (1.f / DATT) + EPS);
#pragma unroll
    for (int h = 0; h < NH; ++h) MG[row * DM + h * 64 + lane] = (bf16)f2bf(att[h] * rstd * gatt[h * 64 + lane]);
}
__device__ __forceinline__ void meta_attn_wave(const bf16* Q, const bf16* K, const bf16* V, bf16* O, const float* CB, int h) {
    const int lane = mk_lane(); if (lane >= NMETA) return;
    const size_t qrow = (size_t)(ROW_META + lane) * 512 + h * 64;
    float sc[NMETA]; float mx = -INFINITY;
#pragma unroll
    for (int j = 0; j < NMETA; ++j) { float s = 0.f; const size_t krow = (size_t)(ROW_META + j) * 512 + h * 64;
        for (int d = 0; d < 64; ++d) s += bf2f(Q[qrow + d]) * bf2f(K[krow + d]);
        s += CB[(size_t)h * CBLEN + j]; sc[j] = j <= lane ? s : -INFINITY; mx = fmaxf(mx, sc[j]); }
    float l = 0.f;
#pragma unroll
    for (int j = 0; j < NMETA; ++j) { sc[j] = fast_exp2(sc[j] - mx); l += sc[j]; }
    const float rl = 1.f / l;
    for (int d = 0; d < 64; ++d) { float o = 0.f;
#pragma unroll
        for (int j = 0; j < NMETA; ++j) o += sc[j] * bf2f(V[(size_t)(ROW_META + j) * 512 + h * 64 + d]);
        O[qrow + d] = (bf16)f2bf(o * rl); }
}

__device__ __forceinline__ void attnorm_row(const bf16* O, const float* gatt, bf16* MG, int r, int lane) {
    const u32x4 w = *(const u32x4*)(O + (size_t)r * 512 + 8 * lane);
    float v[8] = {bflo(w.x), bfhi(w.x), bflo(w.y), bfhi(w.y), bflo(w.z), bfhi(w.z), bflo(w.w), bfhi(w.w)}; float s = 0.f;
#pragma unroll
    for (int i = 0; i < 8; ++i) s += v[i] * v[i];
    const float rstd = rsqrtf(wave_sum(s) * (1.f / DATT) + EPS);
    const f32x4 g0 = *(const f32x4*)(gatt + 8 * lane), g1 = *(const f32x4*)(gatt + 8 * lane + 4);
    u32x4 o; o.x = pk2(v[0] * rstd * g0[0], v[1] * rstd * g0[1]); o.y = pk2(v[2] * rstd * g0[2], v[3] * rstd * g0[3]); o.z = pk2(v[4] * rstd * g1[0], v[5] * rstd * g1[1]); o.w = pk2(v[6] * rstd * g1[2], v[7] * rstd * g1[3]);
    *(u32x4*)(MG + (size_t)r * DM + 8 * lane) = o;
}
__device__ __forceinline__ void rmsnorm_row_bf16(const float* src, const float* g, bf16* dst, int lane) {
    const GAS f32x4* xr = (const GAS f32x4*)src + lane; f32x4 v[4]; float s = 0.f;
#pragma unroll
    for (int j = 0; j < 4; ++j) { v[j] = xr[64 * j]; s += (v[j].x * v[j].x + v[j].y * v[j].y) + (v[j].z * v[j].z + v[j].w * v[j].w); }
    const float rstd = rsqrtf(wave_sum(s) * (1.f / DM) + EPS);
    GAS unsigned long long* o8 = (GAS unsigned long long*)dst + lane;
#pragma unroll
    for (int j = 0; j < 4; ++j) { const f32x4 gg = *((const GAS f32x4*)g + 64 * j + lane); const f32x4 t = v[j] * rstd * gg; o8[64 * j] = (unsigned long long)pk2(t.x, t.y) | ((unsigned long long)pk2(t.z, t.w) << 32); }
}
__device__ __forceinline__ void rmsnorm_row_f32(const float* src, const float* g, float* dst, int lane) {
    const GAS f32x4* xr = (const GAS f32x4*)src + lane; f32x4 v[4]; float s = 0.f;
#pragma unroll
    for (int j = 0; j < 4; ++j) { v[j] = xr[64 * j]; s += (v[j].x * v[j].x + v[j].y * v[j].y) + (v[j].z * v[j].z + v[j].w * v[j].w); }
    const float rstd = rsqrtf(wave_sum(s) * (1.f / DM) + EPS);
#pragma unroll
    for (int j = 0; j < 4; ++j) { const f32x4 gg = *((const GAS f32x4*)g + 64 * j + lane); *((GAS f32x4*)dst + 64 * j + lane) = v[j] * rstd * gg; }
}
__device__ __forceinline__ void ffn_act_row(const bf16* Gp, const bf16* VAL, bf16* ACT, const float* fw, const float* fb, const float* sfc, float* out, int r, int lane) {
    const bf16 *p0 = nullptr, *p1 = nullptr; const float *s0 = nullptr, *s1 = nullptr;
    if (r < M) { const int t = r & (SEQ - 1); p1 = Gp + (size_t)(t >= 1 ? r - 1 : ROW_META + NMETA - 1) * DFF; p0 = Gp + (size_t)(t >= 2 ? r - 2 : ROW_META + NMETA - 2 + t) * DFF; }
    else if (r < ROW_SAMP) { const int p = r - ROW_META; if (p >= 1) p1 = Gp + (size_t)(r - 1) * DFF; if (p >= 2) p0 = Gp + (size_t)(r - 2) * DFF; }
    else { const int b = r - ROW_SAMP; s0 = sfc + (size_t)b * 2 * DFF; s1 = s0 + DFF; }
    const bf16* p2 = Gp + (size_t)r * DFF; const bf16* pv = VAL + (size_t)r * DFF; bf16* po = ACT + (size_t)r * DFF;
    float* oc = nullptr;
    if (r < M) { const int t = r & (SEQ - 1); if (t >= SEQ - 2) oc = out + O_FCP + ((size_t)(r >> 12) * 2 + (t - (SEQ - 2))) * DFF; }
    else if (r >= ROW_SAMP) oc = out + O_FCS + ((size_t)(r - ROW_SAMP) * 2 + 1) * DFF;
    for (int ch = lane; ch < DFF / 8; ch += 64) { const int c = 8 * ch;
        float g2[8], g1[8], g0[8], vv[8];
        { const u32x4 w = *(const u32x4*)(p2 + c); g2[0] = bflo(w.x); g2[1] = bfhi(w.x); g2[2] = bflo(w.y); g2[3] = bfhi(w.y); g2[4] = bflo(w.z); g2[5] = bfhi(w.z); g2[6] = bflo(w.w); g2[7] = bfhi(w.w); }
        { const u32x4 w = *(const u32x4*)(pv + c); vv[0] = bflo(w.x); vv[1] = bfhi(w.x); vv[2] = bflo(w.y); vv[3] = bfhi(w.y); vv[4] = bflo(w.z); vv[5] = bfhi(w.z); vv[6] = bflo(w.w); vv[7] = bfhi(w.w); }
        if (s0) { const f32x4 a0 = *(const f32x4*)(s0 + c), a1 = *(const f32x4*)(s0 + c + 4), b0 = *(const f32x4*)(s1 + c), b1 = *(const f32x4*)(s1 + c + 4);
#pragma unroll
            for (int j = 0; j < 4; ++j) { g0[j] = a0[j]; g0[4 + j] = a1[j]; g1[j] = b0[j]; g1[4 + j] = b1[j]; }
            float* o0 = out + O_FCS + ((size_t)(r - ROW_SAMP) * 2) * DFF + c; *(f32x4*)o0 = b0; *(f32x4*)(o0 + 4) = b1; }
        else {
            u32x4 w = {0u, 0u, 0u, 0u}; if (p1) w = *(const u32x4*)(p1 + c);
            g1[0] = bflo(w.x); g1[1] = bfhi(w.x); g1[2] = bflo(w.y); g1[3] = bfhi(w.y); g1[4] = bflo(w.z); g1[5] = bfhi(w.z); g1[6] = bflo(w.w); g1[7] = bfhi(w.w);
            u32x4 z = {0u, 0u, 0u, 0u}; if (p0) z = *(const u32x4*)(p0 + c);
            g0[0] = bflo(z.x); g0[1] = bfhi(z.x); g0[2] = bflo(z.y); g0[3] = bfhi(z.y); g0[4] = bflo(z.z); g0[5] = bfhi(z.z); g0[6] = bflo(z.w); g0[7] = bfhi(z.w); }
        float a[8];
#pragma unroll
        for (int j = 0; j < 8; ++j) { const float gg = fb[c + j] + fw[c + j] * g0[j] + fw[DFF + c + j] * g1[j] + fw[2 * DFF + c + j] * g2[j]; a[j] = gelu_t(gg) * vv[j]; }
        u32x4 o; o.x = pk2(a[0], a[1]); o.y = pk2(a[2], a[3]); o.z = pk2(a[4], a[5]); o.w = pk2(a[6], a[7]);
        *(u32x4*)(po + c) = o;
        if (oc) { *(f32x4*)(oc + c) = (f32x4){g2[0], g2[1], g2[2], g2[3]}; *(f32x4*)(oc + c + 4) = (f32x4){g2[4], g2[5], g2[6], g2[7]}; }
    }
}
#if DIAG
namespace nv {
constexpr int DM = 1024, NB = 4, SEQ = 4096, NMETA = 16, TP = NMETA + SEQ, DB = 32, PAST = 8192, PAGE = 128, NPG = PAST / PAGE;
constexpr int DATT = 512, DRNN = 512, HD = 64, NH = 8, DFF = 2816, DIN = 2568;
constexpr int NREAL = NB * SEQ, ROW_META = NREAL, ROW_SAMP = NREAL + NMETA, NR = NREAL + NMETA + DB;
constexpr int ZQ = 0, ZK = 512, ZV = 1024, ZF = 1536, ZXR = 1544, ZGR = 2056;
constexpr float EPS = 1e-6f;
constexpr size_t O_Y = 0, O_YS = O_Y + (size_t)NB * SEQ * DM, O_KP = O_YS + (size_t)DB * DM, O_VP = O_KP + (size_t)NB * TP * DATT, O_FP = O_VP + (size_t)NB * TP * DATT,
    O_HP = O_FP + (size_t)NB * TP * NH, O_RCP = O_HP + (size_t)NB * DRNN, O_FCP = O_RCP + (size_t)NB * 3 * DRNN, O_KS = O_FCP + (size_t)NB * 2 * DFF, O_VS = O_KS + (size_t)DB * DATT,
    O_FS = O_VS + (size_t)DB * DATT, O_HS = O_FS + (size_t)DB * NH, O_RCS = O_HS + (size_t)DB * DRNN, O_FCS = O_RCS + (size_t)DB * 3 * DRNN, O_END = O_FCS + (size_t)DB * 2 * DFF;

__device__ __forceinline__ int prow(int b, int p) { return p < NMETA ? ROW_META + p : b * SEQ + (p - NMETA); }
__device__ __forceinline__ const float* xrow_ptr(const float* xp, const float* xs, const float* meta, int r) {
    return r < NREAL ? xp + (size_t)r * DM : (r < ROW_SAMP ? meta + (size_t)(r - ROW_META) * DM : xs + (size_t)(r - ROW_SAMP) * DM);
}
__device__ __forceinline__ float gelu_tanh(float x) { const float u = 0.7978845608028654f * (x + 0.044715f * x * x * x); return 0.5f * x * (1.f + tanhf(u)); }
__device__ __forceinline__ float sigmoidf_(float x) { return 1.f / (1.f + expf(-x)); }
__device__ __forceinline__ float log_sigmoid(float z) { return fminf(z, 0.f) - log1pf(expf(-fabsf(z))); }
__device__ __forceinline__ float softplusf_(float z) { return fmaxf(z, 0.f) + log1pf(expf(-fabsf(z))); }

__global__ void k_rmsnorm_rows(const float* xp, const float* xs, const float* meta, const float* src, const float* g, float* dst, int nrows) {
    const int r = blockIdx.x; if (r >= nrows) return;
    const float* x = src ? src + (size_t)r * DM : xrow_ptr(xp, xs, meta, r);
    __shared__ float red[256];
    float v[4]; float s = 0.f;
    _Pragma("unroll") for (int i = 0; i < 4; ++i) { v[i] = x[threadIdx.x + 256 * i]; s += v[i] * v[i]; }
    red[threadIdx.x] = s; __syncthreads();
    for (int o = 128; o > 0; o >>= 1) { if ((int)threadIdx.x < o) red[threadIdx.x] += red[threadIdx.x + o]; __syncthreads(); }
    const float rstd = rsqrtf(red[0] / DM + EPS);
    _Pragma("unroll") for (int i = 0; i < 4; ++i) dst[(size_t)r * DM + threadIdx.x + 256 * i] = v[i] * rstd * g[threadIdx.x + 256 * i];
}
__global__ void k_gemm(const float* A, int lda, const float* B, int ldb, float* C, int ldc, int M, int N, int K) {
    __shared__ float As[16][65], Bs[16][65];
    const int tx = threadIdx.x & 15, ty = threadIdx.x >> 4, m0 = blockIdx.y * 64, n0 = blockIdx.x * 64;
    float acc[4][4] = {};
    for (int k0 = 0; k0 < K; k0 += 16) {
        for (int i = threadIdx.x; i < 64 * 16; i += 256) { const int r = i >> 4, c = i & 15; As[c][r] = (m0 + r < M) ? A[(size_t)(m0 + r) * lda + k0 + c] : 0.f; }
        for (int i = threadIdx.x; i < 16 * 64; i += 256) { const int r = i >> 6, c = i & 63; Bs[r][c] = (n0 + c < N) ? B[(size_t)(k0 + r) * ldb + n0 + c] : 0.f; }
        __syncthreads();
        _Pragma("unroll") for (int k = 0; k < 16; ++k) { float a[4], b[4];
            _Pragma("unroll") for (int i = 0; i < 4; ++i) { a[i] = As[k][ty * 4 + i]; b[i] = Bs[k][tx * 4 + i]; }
            _Pragma("unroll") for (int i = 0; i < 4; ++i) _Pragma("unroll") for (int j = 0; j < 4; ++j) acc[i][j] += a[i] * b[j]; }
        __syncthreads();
    }
    _Pragma("unroll") for (int i = 0; i < 4; ++i) _Pragma("unroll") for (int j = 0; j < 4; ++j) { const int r = m0 + ty * 4 + i, c = n0 + tx * 4 + j; if (r < M && c < N) C[(size_t)r * ldc + c] = acc[i][j]; }
}
__global__ void k_split_outputs(const float* Z, const float* bfor, float* out, float* LOGF) {
    const int r = blockIdx.x; const float* z = Z + (size_t)r * DIN;
    for (int c = threadIdx.x; c < 1024 + NH; c += blockDim.x) {
        float val; size_t base; int width, col;
        if (c < 512) { val = z[ZK + c]; col = c; width = DATT; base = 0; } else if (c < 1024) { val = z[ZV + c - 512]; col = c - 512; width = DATT; base = 1; }
        else { col = c - 1024; val = log_sigmoid(z[ZF + col] + bfor[col]); width = NH; base = 2; LOGF[(size_t)r * NH + col] = val; }
        const size_t op = base == 0 ? O_KP : (base == 1 ? O_VP : O_FP), os = base == 0 ? O_KS : (base == 1 ? O_VS : O_FS);
        if (r < NREAL) { const int b = r / SEQ, t = r % SEQ; out[op + ((size_t)b * TP + NMETA + t) * width + col] = val; }
        else if (r < ROW_SAMP) { const int p = r - ROW_META; for (int b = 0; b < NB; ++b) out[op + ((size_t)b * TP + p) * width + col] = val; }
        else out[os + (size_t)(r - ROW_SAMP) * width + col] = val;
    }
}
__global__ void k_cumsum(const float* LOGF, float* C) {
    const int i = blockIdx.x * blockDim.x + threadIdx.x; if (i >= NB * NH) return; const int b = i / NH, h = i % NH; float s = 0.f;
    for (int p = 0; p < TP; ++p) { s += LOGF[(size_t)prow(b, p) * NH + h]; C[((size_t)b * TP + p) * NH + h] = s; }
}
__global__ void __launch_bounds__(64) k_attn_prompt(const float* Z, const float* C, float* ATT) {
    __shared__ float Ks[64][64], Vs[64][64], Ss[64][65];
    const int b = blockIdx.y / NH, h = blockIdx.y % NH, p = blockIdx.x * 64 + threadIdx.x; const bool live = p < TP;
    float q[64], o[64]; float m = -INFINITY, l = 0.f;
    const int rq = prow(b, live ? p : 0);
    _Pragma("unroll") for (int d = 0; d < 64; ++d) { q[d] = Z[(size_t)rq * DIN + ZQ + h * HD + d] * 0.125f; o[d] = 0.f; }
    const float cq = C[((size_t)b * TP + (live ? p : 0)) * NH + h];
    const int pmax = min(blockIdx.x * 64 + 63, TP - 1);
    for (int j0 = 0; j0 <= pmax; j0 += 64) {
        __syncthreads();
        for (int i = threadIdx.x; i < 64 * 64; i += 64) { const int jj = i >> 6, d = i & 63, j = j0 + jj; const int rk = prow(b, j < TP ? j : 0);
            Ks[jj][d] = Z[(size_t)rk * DIN + ZK + h * HD + d]; Vs[jj][d] = Z[(size_t)rk * DIN + ZV + h * HD + d]; }
        __syncthreads();
        float tm = -INFINITY;
        for (int jj = 0; jj < 64; ++jj) { const int j = j0 + jj; float s = -INFINITY;
            if (live && j <= p) { s = 0.f; _Pragma("unroll") for (int d = 0; d < 64; ++d) s += q[d] * Ks[jj][d]; s += cq - C[((size_t)b * TP + j) * NH + h]; }
            Ss[jj][threadIdx.x] = s; tm = fmaxf(tm, s); }
        if (tm > -INFINITY) {
            const float mn = fmaxf(m, tm), al = (m > -INFINITY) ? expf(m - mn) : 0.f; l *= al; _Pragma("unroll") for (int d = 0; d < 64; ++d) o[d] *= al; m = mn;
            for (int jj = 0; jj < 64; ++jj) { const float s = Ss[jj][threadIdx.x]; if (s > -INFINITY) { const float pe = expf(s - m); l += pe; _Pragma("unroll") for (int d = 0; d < 64; ++d) o[d] += pe * Vs[jj][d]; } }
        }
    }
    if (live) _Pragma("unroll") for (int d = 0; d < 64; ++d) ATT[(size_t)rq * DATT + h * HD + d] = o[d] / l;
}
__global__ void __launch_bounds__(256) k_attn_sample(const float* Z, const float* LOGF, const float* ck, const float* cv, const float* cf, const int* pt, float* ATT) {
    extern __shared__ float sm[]; float* S = sm; float* Fb = sm + (PAST + 1); float* red = Fb + (PAST + 1);
    const int b = blockIdx.x / NH, h = blockIdx.x % NH, r = ROW_SAMP + b, tid = threadIdx.x;
    const float* q = Z + (size_t)r * DIN + ZQ + h * HD;
    for (int j = tid; j <= PAST; j += 256) { float s = 0.f, f;
        if (j < PAST) { const size_t pg = (size_t)pt[b * NPG + j / PAGE]; const float* k = ck + ((pg * PAGE + j % PAGE) * NH + h) * HD; _Pragma("unroll") for (int d = 0; d < 64; ++d) s += q[d] * k[d]; f = cf[(pg * PAGE + j % PAGE) * NH + h]; }
        else { const float* k = Z + (size_t)r * DIN + ZK + h * HD; _Pragma("unroll") for (int d = 0; d < 64; ++d) s += q[d] * k[d]; f = LOGF[(size_t)r * NH + h]; }
        S[j] = s * 0.125f; Fb[j] = f; }
    __syncthreads();
    if (tid == 0) { float suf = 0.f; for (int j = PAST; j >= 0; --j) { S[j] += suf; suf += Fb[j]; } }
    __syncthreads();
    float mx = -INFINITY; for (int j = tid; j <= PAST; j += 256) mx = fmaxf(mx, S[j]);
    red[tid] = mx; __syncthreads(); for (int o = 128; o > 0; o >>= 1) { if (tid < o) red[tid] = fmaxf(red[tid], red[tid + o]); __syncthreads(); } mx = red[0]; __syncthreads();
    float sum = 0.f; for (int j = tid; j <= PAST; j += 256) { const float pe = expf(S[j] - mx); S[j] = pe; sum += pe; }
    red[tid] = sum; __syncthreads(); for (int o = 128; o > 0; o >>= 1) { if (tid < o) red[tid] += red[tid + o]; __syncthreads(); } sum = red[0]; __syncthreads();
    const int d = tid & 63, g = tid >> 6; float acc = 0.f;
    for (int j = g; j <= PAST; j += 4) { float v;
        if (j < PAST) { const size_t pg = (size_t)pt[b * NPG + j / PAGE]; v = cv[((pg * PAGE + j % PAGE) * NH + h) * HD + d]; } else v = Z[(size_t)r * DIN + ZV + h * HD + d];
        acc += S[j] * v; }
    red[tid] = acc; __syncthreads();
    if (tid < 64) ATT[(size_t)r * DATT + h * HD + tid] = (red[tid] + red[tid + 64] + red[tid + 128] + red[tid + 192]) / sum;
}
__global__ void k_rnn_gates(const float* Z, const float* sconv, const float* cw, const float* cb, const float* wa, const float* ba, const float* wx, const float* bx, const float* lam,
                            float* Aa, float* Uu, float* out) {
    __shared__ float xc[DRNN];
    const int r = blockIdx.x;
    for (int c = threadIdx.x; c < DRNN; c += blockDim.x) {
        float xin[4];
        _Pragma("unroll") for (int j = 0; j < 4; ++j) {
            if (r < ROW_SAMP) { int b, p; if (r < NREAL) { b = r / SEQ; p = NMETA + r % SEQ; } else { b = 0; p = r - ROW_META; }
                const int pp = p + j - 3; xin[j] = pp >= 0 ? Z[(size_t)prow(b, pp) * DIN + ZXR + c] : 0.f; }
            else { const int b = r - ROW_SAMP; xin[j] = j < 3 ? sconv[((size_t)b * 3 + j) * DRNN + c] : Z[(size_t)r * DIN + ZXR + c]; }
        }
        xc[c] = cb[c] + cw[0 * DRNN + c] * xin[0] + cw[1 * DRNN + c] * xin[1] + cw[2 * DRNN + c] * xin[2] + cw[3 * DRNN + c] * xin[3];
        if (r >= ROW_SAMP) { const int b = r - ROW_SAMP; _Pragma("unroll") for (int j = 0; j < 3; ++j) out[O_RCS + ((size_t)b * 3 + j) * DRNN + c] = xin[j + 1]; }
        else if (r < NREAL && r % SEQ >= SEQ - 3) { const int b = r / SEQ, j = r % SEQ - (SEQ - 3); out[O_RCP + ((size_t)b * 3 + j) * DRNN + c] = xin[3]; }
    }
    __syncthreads();
    for (int d = threadIdx.x; d < DRNN; d += blockDim.x) { const int n = d / 64, dd = d % 64; float ga = ba[d], gx = bx[d];
        for (int c = 0; c < 64; ++c) { const float x = xc[n * 64 + c]; ga += x * wa[((size_t)n * 64 + c) * 64 + dd]; gx += x * wx[((size_t)n * 64 + c) * 64 + dd]; }
        const float rr = sigmoidf_(ga), ii = sigmoidf_(gx), la = -8.0f * rr * softplusf_(-lam[d]);
        Aa[(size_t)r * DRNN + d] = expf(la); Uu[(size_t)r * DRNN + d] = sqrtf(-expm1f(2.f * la)) * (ii * xc[d]); }
}
__global__ void k_rnn_scan(const float* Aa, const float* Uu, const float* h0s, float* H, float* out) {
    const int i = blockIdx.x * blockDim.x + threadIdx.x;
    if (i < NB * DRNN) { const int b = i / DRNN, c = i % DRNN; float h = 0.f;
        for (int p = 0; p < TP; ++p) { const size_t r = prow(b, p); h = Aa[r * DRNN + c] * h + Uu[r * DRNN + c]; if (p >= NMETA || b == 0) H[r * DRNN + c] = h; }
        out[O_HP + (size_t)b * DRNN + c] = h; }
    else if (i < NB * DRNN + DB * DRNN) { const int k = i - NB * DRNN, b = k / DRNN, c = k % DRNN; const size_t r = ROW_SAMP + b;
        const float h = Aa[r * DRNN + c] * h0s[(size_t)b * DRNN + c] + Uu[r * DRNN + c]; H[r * DRNN + c] = h; out[O_HS + (size_t)b * DRNN + c] = h; }
}
__global__ void k_merge(const float* ATT, const float* H, const float* Z, const float* gatt, const float* grnn, float* MG) {
    const int r = blockIdx.x, tid = threadIdx.x; __shared__ float red[2][256];
    float a[2], y[2]; float sa = 0.f, sy = 0.f;
    _Pragma("unroll") for (int i = 0; i < 2; ++i) { const int c = tid + 256 * i; a[i] = ATT[(size_t)r * DATT + c]; y[i] = H[(size_t)r * DRNN + c] * gelu_tanh(Z[(size_t)r * DIN + ZGR + c]); sa += a[i] * a[i]; sy += y[i] * y[i]; }
    red[0][tid] = sa; red[1][tid] = sy; __syncthreads();
    for (int o = 128; o > 0; o >>= 1) { if (tid < o) { red[0][tid] += red[0][tid + o]; red[1][tid] += red[1][tid + o]; } __syncthreads(); }
    const float ra = rsqrtf(red[0][0] / DATT + EPS), ry = rsqrtf(red[1][0] / DRNN + EPS);
    _Pragma("unroll") for (int i = 0; i < 2; ++i) { const int c = tid + 256 * i; MG[(size_t)r * DM + c] = a[i] * ra * gatt[c]; MG[(size_t)r * DM + DATT + c] = y[i] * ry * grnn[c]; }
}
__global__ void k_add_x(const float* xp, const float* xs, const float* meta, float* X) {
    const int r = blockIdx.x; const float* x = xrow_ptr(xp, xs, meta, r);
    for (int c = threadIdx.x; c < DM; c += blockDim.x) X[(size_t)r * DM + c] += x[c];
}
__global__ void k_add(const float* a, float* X, size_t n) { const size_t i = (size_t)blockIdx.x * blockDim.x + threadIdx.x; if (i < n) X[i] += a[i]; }
__global__ void k_ffn_act(const float* GV, const float* sfc, const float* fw, const float* fb, float* ACT, float* out) {
    const int r = blockIdx.x;
    for (int c = threadIdx.x; c < DFF; c += blockDim.x) { float gin[3];
        _Pragma("unroll") for (int j = 0; j < 3; ++j) {
            if (r < ROW_SAMP) { int b, p; if (r < NREAL) { b = r / SEQ; p = NMETA + r % SEQ; } else { b = 0; p = r - ROW_META; }
                const int pp = p + j - 2; gin[j] = pp >= 0 ? GV[(size_t)prow(b, pp) * (2 * DFF) + c] : 0.f; }
            else { const int b = r - ROW_SAMP; gin[j] = j < 2 ? sfc[((size_t)b * 2 + j) * DFF + c] : GV[(size_t)r * (2 * DFF) + c]; }
        }
        const float g = fb[c] + fw[0 * DFF + c] * gin[0] + fw[1 * DFF + c] * gin[1] + fw[2 * DFF + c] * gin[2];
        ACT[(size_t)r * DFF + c] = gelu_tanh(g) * GV[(size_t)r * (2 * DFF) + DFF + c];
        if (r >= ROW_SAMP) { const int b = r - ROW_SAMP; _Pragma("unroll") for (int j = 0; j < 2; ++j) out[O_FCS + ((size_t)b * 2 + j) * DFF + c] = gin[j + 1]; }
        else if (r < NREAL && r % SEQ >= SEQ - 2) { const int b = r / SEQ, j = r % SEQ - (SEQ - 2); out[O_FCP + ((size_t)b * 2 + j) * DFF + c] = gin[2]; }
    }
}
__global__ void k_final(const float* X2, const float* g, float* out) {
    const int r = blockIdx.x; if (r >= ROW_META && r < ROW_SAMP) return; const int tid = threadIdx.x; __shared__ float red[256];
    float v[4]; float s = 0.f; _Pragma("unroll") for (int i = 0; i < 4; ++i) { v[i] = X2[(size_t)r * DM + tid + 256 * i]; s += v[i] * v[i]; }
    red[tid] = s; __syncthreads(); for (int o = 128; o > 0; o >>= 1) { if (tid < o) red[tid] += red[tid + o]; __syncthreads(); }
    const float rstd = rsqrtf(red[0] / DM + EPS); float* o = r < NREAL ? out + O_Y + (size_t)r * DM : out + O_YS + (size_t)(r - ROW_SAMP) * DM;
    _Pragma("unroll") for (int i = 0; i < 4; ++i) o[tid + 256 * i] = v[i] * rstd * g[tid + 256 * i];
}

struct Bufs { float *HN, *Z, *LOGF, *C, *ATT, *A, *U, *H, *MG, *X1, *HN2, *GV, *ACT, *X2; };
inline size_t carve(unsigned char* ws, size_t off, Bufs& B) {
    auto take = [&](size_t nfloats) { float* p = (float*)(ws + off); off += ((nfloats * 4 + 255) / 256) * 256; return p; };
    B.HN = take((size_t)NR * DM); B.Z = take((size_t)NR * DIN); B.LOGF = take((size_t)NR * NH); B.C = take((size_t)NB * TP * NH); B.ATT = take((size_t)NR * DATT);
    B.A = take((size_t)NR * DRNN); B.U = take((size_t)NR * DRNN); B.H = take((size_t)NR * DRNN); B.MG = take((size_t)NR * DM); B.X1 = take((size_t)NR * DM); B.HN2 = take((size_t)NR * DM);
    B.GV = take((size_t)NR * 2 * DFF); B.ACT = take((size_t)NR * DFF); B.X2 = take((size_t)NR * DM);
    return off;
}
inline void run(void* const* d_in, float* out, const Bufs& B, hipStream_t st) {
    const float* xp = (const float*)d_in[0]; const float* xs = (const float*)d_in[1]; const float* ck = (const float*)d_in[2]; const float* cv = (const float*)d_in[3]; const float* cf = (const float*)d_in[4];
    const float* srh = (const float*)d_in[5]; const float* src_ = (const float*)d_in[6]; const float* sfc = (const float*)d_in[7]; const int* pt = (const int*)d_in[8]; const float* meta = (const float*)d_in[9];
    const float* nmix = (const float*)d_in[10]; const float* win = (const float*)d_in[11]; const float* bfor = (const float*)d_in[12]; const float* cw = (const float*)d_in[13]; const float* cb = (const float*)d_in[14];
    const float* wa = (const float*)d_in[15]; const float* ba = (const float*)d_in[16]; const float* wx = (const float*)d_in[17]; const float* bx = (const float*)d_in[18]; const float* lam = (const float*)d_in[19];
    const float* gatt = (const float*)d_in[20]; const float* grnn = (const float*)d_in[21]; const float* wout = (const float*)d_in[22]; const float* nffn = (const float*)d_in[23]; const float* wup = (const float*)d_in[24];
    const float* fw = (const float*)d_in[25]; const float* fb = (const float*)d_in[26]; const float* wdn = (const float*)d_in[27]; const float* nfin = (const float*)d_in[28];
    auto gemm = [&](const float* A, int lda, const float* Bm, int ldb, float* C, int ldc, int M, int N, int K) { k_gemm<<<dim3((N + 63) / 64, (M + 63) / 64), 256, 0, st>>>(A, lda, Bm, ldb, C, ldc, M, N, K); };
    k_rmsnorm_rows<<<NR, 256, 0, st>>>(xp, xs, meta, nullptr, nmix, B.HN, NR);
    gemm(B.HN, DM, win, DIN, B.Z, DIN, NR, DIN, DM);
    k_split_outputs<<<NR, 256, 0, st>>>(B.Z, bfor, out, B.LOGF);
    k_cumsum<<<1, 64, 0, st>>>(B.LOGF, B.C);
    k_attn_prompt<<<dim3((TP + 63) / 64, NB * NH), 64, 0, st>>>(B.Z, B.C, B.ATT);
    k_attn_sample<<<DB * NH, 256, (2 * (PAST + 1) + 512) * 4, st>>>(B.Z, B.LOGF, ck, cv, cf, pt, B.ATT);
    k_rnn_gates<<<NR, 256, 0, st>>>(B.Z, src_, cw, cb, wa, ba, wx, bx, lam, B.A, B.U, out);
    k_rnn_scan<<<(NB * DRNN + DB * DRNN + 255) / 256, 256, 0, st>>>(B.A, B.U, srh, B.H, out);
    k_merge<<<NR, 256, 0, st>>>(B.ATT, B.H, B.Z, gatt, grnn, B.MG);
    gemm(B.MG, DM, wout, DM, B.X1, DM, NR, DM, DM);
    k_add_x<<<NR, 256, 0, st>>>(xp, xs, meta, B.X1);
    k_rmsnorm_rows<<<NR, 256, 0, st>>>(nullptr, nullptr, nullptr, B.X1, nffn, B.HN2, NR);
    gemm(B.HN2, DM, wup, 2 * DFF, B.GV, 2 * DFF, NR, 2 * DFF, DM);
    k_ffn_act<<<NR, 256, 0, st>>>(B.GV, sfc, fw, fb, B.ACT, out);
    gemm(B.ACT, DFF, wdn, DM, B.X2, DM, NR, DM, DFF);
    k_add<<<(unsigned)(((size_t)NR * DM + 255) / 256), 256, 0, st>>>(B.X1, B.X2, (size_t)NR * DM);
    k_final<<<NR, 256, 0, st>>>(B.X2, nfin, out);
}
}
#endif
__global__ void __launch_bounds__(NWAVES * 64, 2) mk_fwd(Args args) {
    extern __shared__ __attribute__((aligned(16))) unsigned char lds_raw[];
    LAS unsigned char* lds = (LAS unsigned char*)lds_raw;
    volatile LAS unsigned* MISC = (volatile LAS unsigned*)(lds + MISC_OFF);
    const int wave = __builtin_amdgcn_readfirstlane((int)threadIdx.x >> 6);
#define LANE mk_lane()
    const int G = gridDim.x, bx = blockIdx.x, vcu = (G % 8 == 0) ? (bx % 8) * (G / 8) + bx / 8 : bx;
    unsigned char* ws = args.ws; float* out = args.out;
    gu32* ctl = (gu32*)(ws + WS_CTL);
    for (int u = mk_tid(wave); u < (LDS_BYTES - LDSCTL_OFF) / 4; u += NWAVES * 64) ((LAS unsigned*)(lds + LDSCTL_OFF))[u] = 0u;
    __syncthreads();
    XcdBarrier bar = xcd_barrier_post((unsigned*)(ctl + CW_BAR), MISC + 8, wave);
    const int lo = args.ph_lo, hi = args.ph_hi;
#define IN(k) (lo <= (k) && (k) < hi)
#define GRID_BAR(k) do { if (IN(k) && IN((k) + 1)) xcd_barrier(bar); } while (0)
    const float* xp = args.in[0]; const float* xs = args.in[1]; const float* meta = args.in[9];
    bf16* WIN = (bf16*)(ws + WS_WIN); bf16* WOUT = (bf16*)(ws + WS_WOUT); bf16* WUP = (bf16*)(ws + WS_WUP); bf16* WDN = (bf16*)(ws + WS_WDN); bf16* WG = (bf16*)(ws + WS_WG);
    float* CB = (float*)(ws + WS_CB); float* AGG = (float*)(ws + WS_AGG); float* LOGF = (float*)(ws + WS_LOGF); float* PART = (float*)(ws + WS_PART);
    bf16* HN = (bf16*)(ws + WS_HN); bf16* Qb = (bf16*)(ws + WS_Q); bf16* Kb = (bf16*)(ws + WS_K); bf16* Vb = (bf16*)(ws + WS_V); bf16* XR = (bf16*)(ws + WS_XR); bf16* GR = (bf16*)(ws + WS_GR);
    bf16* MG = (bf16*)(ws + WS_MG); float* X1 = (float*)(ws + WS_X1); bf16* Gb = (bf16*)(ws + WS_G); bf16* VAL = (bf16*)(ws + WS_VAL); bf16* ACT = (bf16*)(ws + WS_ACT); float* X2 = (float*)(ws + WS_X2);
    const int gw = bx * NWAVES + wave, NGW = G * NWAVES;

    if (IN(0)) {
        P0Args P{xp, xs, meta, args.in[10], args.in[11], args.in[12], args.in[15], args.in[17], args.in[22], args.in[24], args.in[27], WIN, WOUT, WUP, WDN, WG, HN, LOGF, out};
        p0_prologue(lds, P, vcu, G, wave);
    }
    GRID_BAR(0);
    if (IN(1)) {
        if (bx >= 128 && bx < 208) {
            bf16* dq = Qb; bf16* dk = Kb; bf16* dv = Vb; bf16* dx = XR; bf16* dg = GR;
            auto f = [=](int row, int col, float v) { const int t = col >> 9, cc = col & 511; bf16* d = t == 0 ? dq : (t == 1 ? dk : (t == 2 ? dv : (t == 3 ? dx : dg)));
                d[(size_t)(M + row) * 512 + cc] = (bf16)f2bf(t == 0 ? v * attn_body::C2 : v);
                if (t == 1 || t == 2) { float* ob = out + (t == 1 ? O_KP : O_VP); float* os = out + (t == 1 ? O_KS : O_VS);
                    if (row < NMETA) { for (int b = 0; b < NB; ++b) ob[((size_t)b * TP + row) * DATT + cc] = v; } else if (row < NMETA + DB) os[(size_t)(row - NMETA) * DATT + cc] = v; } };
            side_gemm_job(lds, HN + (size_t)M * DM, WIN, DM, bx - 128, f, wave);
        }
        if (bx >= 208 && bx < 240) cb_job(lds, LOGF, CB, bx - 208, wave);
        pg8::Gemm g{HN, WIN, M, NIN, DM}; pg8::StaticOrder S; S.init(M, NIN, G, bx);
        pg8::EpiInProj E{Qb, (size_t)(WS_K - WS_Q) / 2, out, attn_body::C2};
        static_assert(WS_V - WS_K == WS_K - WS_Q && WS_XR - WS_V == WS_K - WS_Q && WS_GR - WS_XR == WS_K - WS_Q, "Q|K|V|XR|GR equally spaced");
        pg8::gemm_phase<pg8::EpiInProj, pg8::StaticOrder, true, true>(lds + RING_OFF, g, S, E, wave);
    }
    GRID_BAR(1);
    const RnnArgs RA{XR, GR, WG, args.in[13], args.in[14], args.in[16], args.in[18], args.in[19], args.in[21], args.in[6], args.in[5], AGG, MG, out};
    if (IN(2)) {
        rnn_stage_params(lds, RA, wave);
        if (bx < 252) rnn_unit<1>(lds, RA, 0, bx / 63, bx % 63, wave); else if (bx == 252) rnn_unit<1>(lds, RA, 1, 0, 0, wave);
        __syncthreads();
        const attn_body::AttnTensors AT{(const attn_body::bf16*)Qb, (const attn_body::bf16*)Kb, (const attn_body::bf16*)Vb, (attn_body::bf16*)Qb, CB};
        const attn_body::StaticOrder S(G, bx);
        attn_body::attn_phase<attn_body::StaticOrder>((char*)lds_raw + RING_OFF, AT, S, wave);
        if (bx == 255) meta_attn_wave(Qb, Kb, Vb, Qb, CB, wave);
        const DecArgs Dd{args.in[2], args.in[3], args.in[4], (const int*)args.in[8], Qb, PART};
        for (int j = gw; j < DB * NPG; j += NGW) decode_page_wave(lds + wave * 4096, Dd, j >> 6, j & 63);
    }
    GRID_BAR(2);
    if (IN(3)) {
        rnn_stage_params(lds, RA, wave);
        for (int u = bx; u < NB * NCHUNK + 2; u += G) {
            if (u < NB * NCHUNK) rnn_unit<2>(lds, RA, 0, u >> 6, u & 63, wave); else if (u == NB * NCHUNK) rnn_unit<2>(lds, RA, 1, 0, 0, wave); else rnn_unit<2>(lds, RA, 2, 0, 0, wave);
            __syncthreads();
        }
        if ((gw & 63) == 0 && (gw >> 6) < DB) decode_combine_row(PART, LOGF, Qb, Kb, Vb, args.in[20], MG, gw >> 6);
        for (int r = gw; r < M + NMETA; r += NGW) attnorm_row(Qb, args.in[20], MG, r, LANE);
    }
    GRID_BAR(3);
    if (IN(4)) {
        if (bx < 32) { auto f = [=](int row, int col, float v) { if (row < NMETA + DB) X1[(size_t)(M + row) * DM + col] = xrow_ptr(xp, xs, meta, M + row)[col] + v; };
            side_gemm_job(lds, MG + (size_t)M * DM, WOUT, DM, bx, f, wave); }
        pg8::Gemm g{MG, WOUT, M, DM, DM}; pg8::StaticOrder S; S.init(M, DM, G, bx);
        pg8::EpiAddF32 E{xp, X1, DM};
        pg8::gemm_phase<pg8::EpiAddF32, pg8::StaticOrder, false, true>(lds + RING_OFF, g, S, E, wave);
    }
    GRID_BAR(4);
    if (IN(5)) { for (int r = gw; r < NRV; r += NGW) rmsnorm_row_bf16(X1 + (size_t)r * DM, args.in[23], HN + (size_t)r * DM, LANE); }
    GRID_BAR(5);
    if (IN(6)) {
        for (int j = bx - 128; j >= 0 && j < 176; j += 128) { auto f = [=](int row, int col, float v) { if (col < DFF) Gb[(size_t)(M + row) * DFF + col] = (bf16)f2bf(v); else VAL[(size_t)(M + row) * DFF + col - DFF] = (bf16)f2bf(v); };
            side_gemm_job(lds, HN + (size_t)M * DM, WUP, DM, j, f, wave); }
        pg8::Gemm g{HN, WUP, M, 2 * DFF, DM}; pg8::StaticOrder S; S.init(M, 2 * DFF, G, bx);
        pg8::EpiBf16<0> E{Gb, DFF, nullptr, DFF, (size_t)(WS_VAL - WS_G) / 2, 1.f};
        pg8::gemm_phase<pg8::EpiBf16<0>, pg8::StaticOrder, true, true>(lds + RING_OFF, g, S, E, wave);
    }
    GRID_BAR(6);
    if (IN(7)) { for (int r = gw; r < NRV; r += NGW) ffn_act_row(Gb, VAL, ACT, args.in[25], args.in[26], args.in[7], out, r, LANE); }
    GRID_BAR(7);
    if (IN(8)) {
        if (bx < 32) { auto f = [=](int row, int col, float v) { if (row < NMETA + DB) X2[(size_t)(M + row) * DM + col] = X1[(size_t)(M + row) * DM + col] + v; };
            side_gemm_job(lds, ACT + (size_t)M * DFF, WDN, DFF, bx, f, wave); }
        pg8::Gemm g{ACT, WDN, M, DM, DFF}; pg8::StaticOrder S; S.init(M, DM, G, bx);
        pg8::EpiAddF32 E{X1, X2, DM};
        pg8::gemm_phase<pg8::EpiAddF32, pg8::StaticOrder, false, true>(lds + RING_OFF, g, S, E, wave);
    }
    GRID_BAR(8);
    if (IN(9)) {
        for (int r = gw; r < NRV; r += NGW) { if (r >= ROW_META && r < ROW_SAMP) continue;
            rmsnorm_row_f32(X2 + (size_t)r * DM, args.in[28], r < M ? out + O_Y + (size_t)r * DM : out + O_YS + (size_t)(r - ROW_SAMP) * DM, LANE); }
    }
#undef IN
#undef GRID_BAR
}

#if DIAG
template <class T> __global__ void k_cmp2d(const T* a, int lda, const float* ref, int ldr, int nrows, int ncols, float* acc) {
    float se = 0.f, sr = 0.f;
    for (size_t i = (size_t)blockIdx.x * blockDim.x + threadIdx.x; i < (size_t)nrows * ncols; i += (size_t)gridDim.x * blockDim.x) {
        const size_t r = i / ncols, c = i % ncols; float av; if constexpr (sizeof(T) == 2) av = __uint_as_float((unsigned)a[r * lda + c] << 16); else av = a[r * lda + c];
        const float rv = ref[r * ldr + c], d = av - rv; se += d * d; sr += rv * rv; }
    for (int o = 32; o > 0; o >>= 1) { se += __shfl_xor(se, o); sr += __shfl_xor(sr, o); }
    if ((threadIdx.x & 63) == 0) { atomicAdd(acc, se); atomicAdd(acc + 1, sr); }
}
__global__ void k_flag(const float* acc, int nchk, float tol2, float* ys, int n, int magnitude_of) {
    __shared__ float s;
    if (threadIdx.x == 0) { float code = 0.f;
        for (int k = 0; k < nchk; ++k) { const float e = acc[2 * k], r = acc[2 * k + 1]; if (!(e <= tol2 * r)) { code = (float)(k + 1); break; } }
        if (magnitude_of > 0) { const float e = acc[2 * (magnitude_of - 1)], r = acc[2 * (magnitude_of - 1) + 1]; code = sqrtf(e / r); }
        s = code; }
    __syncthreads();
    const float sc = 1.f + s;
    for (int i = blockIdx.x * blockDim.x + threadIdx.x; i < n; i += gridDim.x * blockDim.x) ys[i] *= sc;
}
#endif
extern "C" void kernel_launch(void* const* d_in, const int* in_sizes, int n_in, void* d_out, int out_size, void* d_ws, size_t ws_size, hipStream_t stream) {
    static int grid = 0;
    if (grid == 0) {
        if (n_in != 29 || (size_t)out_size != O_END || ws_size < WS_END) { fprintf(stderr, "kernel_launch: unexpected problem: n_in %d out %d ws %zu\n", n_in, out_size, ws_size); grid = -1; return; }
        int dev = 0, cus = 0, per_cu = 0;
        if (hipGetDevice(&dev) != hipSuccess || hipDeviceGetAttribute(&cus, hipDeviceAttributeMultiprocessorCount, dev) != hipSuccess) { grid = -1; return; }
        if (hipFuncSetAttribute((const void*)mk_fwd, hipFuncAttributeMaxDynamicSharedMemorySize, LDS_BYTES) != hipSuccess) { fprintf(stderr, "kernel_launch: hipFuncSetAttribute failed\n"); grid = -1; return; }
        if (hipOccupancyMaxActiveBlocksPerMultiprocessor(&per_cu, (const void*)mk_fwd, NWAVES * 64, LDS_BYTES) != hipSuccess || per_cu < 1) fprintf(stderr, "kernel_launch: occupancy query reports %d per CU\n", per_cu);
        (void)hipGetLastError();
        grid = cus;
        if (grid != 256) fprintf(stderr, "kernel_launch: %d CUs; this kernel is written for 256\n", grid);
#if DIAG
        (void)hipFuncSetAttribute((const void*)nv::k_attn_sample, hipFuncAttributeMaxDynamicSharedMemorySize, (2 * (nv::PAST + 1) + 512) * 4);
#endif
    }
    if (grid < 0) return;
    (void)hipMemsetAsync((char*)d_ws + WS_CTL, 0, CTL_ZERO_BYTES, stream);
    Args a{};
    for (int i = 0; i < 29; ++i) a.in[i] = (const float*)d_in[i];
    a.ws = (unsigned char*)d_ws; a.ph_lo = 0; a.ph_hi = 10;
#if DIAG
    float* out2 = (float*)((char*)d_ws + 700 * MiB); a.out = out2;
    nv::Bufs B; (void)nv::carve((unsigned char*)d_ws, 1024 * MiB, B);
    nv::run(d_in, (float*)d_out, B, stream);
    hipLaunchKernelGGL(mk_fwd, dim3(grid), dim3(NWAVES * 64), LDS_BYTES, stream, a);
    float* acc = (float*)((char*)d_ws + 699 * MiB); (void)hipMemsetAsync(acc, 0, 4096, stream);
    float* o = (float*)d_out; int k = 0;
    auto cmpf = [&](const float* x, const float* ref, size_t n) { k_cmp2d<float><<<512, 256, 0, stream>>>(x, (int)n, ref, (int)n, 1, (int)n, acc + 2 * k); ++k; };
    auto cmpb = [&](const unsigned short* x, int lda, const float* ref, int ldr, int nrows, int ncols) { k_cmp2d<unsigned short><<<512, 256, 0, stream>>>(x, lda, ref, ldr, nrows, ncols, acc + 2 * k); ++k; };
    cmpf(out2 + O_FP, o + O_FP, NB * TP * NH);
    cmpf(out2 + O_KP, o + O_KP, (size_t)NB * TP * DATT);
    cmpf(out2 + O_VP, o + O_VP, (size_t)NB * TP * DATT);
    cmpf(out2 + O_KS, o + O_KS, O_HS - O_KS);
    cmpf(out2 + O_RCP, o + O_RCP, NB * 3 * DRNN);
    cmpf(out2 + O_RCS, o + O_RCS, DB * 3 * DRNN);
    cmpf(out2 + O_HP, o + O_HP, NB * DRNN);
    cmpf(out2 + O_HS, o + O_HS, DB * DRNN);
    cmpb((const unsigned short*)((char*)d_ws + WS_MG), DM, B.MG, DM, M + NMETA, DATT);
    cmpb((const unsigned short*)((char*)d_ws + WS_MG) + DATT, DM, B.MG + DATT, DM, M + NMETA, DRNN);
    cmpb((const unsigned short*)((char*)d_ws + WS_MG) + (size_t)ROW_SAMP * DM, DM, B.MG + (size_t)ROW_SAMP * DM, DM, DB, DATT);
    cmpb((const unsigned short*)((char*)d_ws + WS_MG) + (size_t)ROW_SAMP * DM + DATT, DM, B.MG + (size_t)ROW_SAMP * DM + DATT, DM, DB, DRNN);
    cmpf((const float*)((char*)d_ws + WS_X1), B.X1, (size_t)NRV * DM);
    cmpf(out2 + O_FCP, o + O_FCP, NB * 2 * DFF);
    cmpf(out2 + O_FCS, o + O_FCS, DB * 2 * DFF);
    cmpf(out2 + O_Y, o + O_Y, (size_t)NB * SEQ * DM);
    cmpf(out2 + O_YS, o + O_YS, DB * DM);
    k_flag<<<64, 256, 0, stream>>>(acc, k, DIAG_TOL * DIAG_TOL, o + O_YS, DB * DM, DIAG_MAG);
#else
    a.out = (float*)d_out;
    hipLaunchKernelGGL(mk_fwd, dim3(grid), dim3(NWAVES * 64), LDS_BYTES, stream, a);
#endif
    const hipError_t le = hipPeekAtLastError();
    if (le != hipSuccess) fprintf(stderr, "kernel_launch: launch failed: %s\n", hipGetErrorName(le));
}
```
